# Optimizing an MI355X kernel written in HIP

```python
import math
import jax, jax.numpy as jnp
from jax import lax
import numpy as np


D_MODEL = 1024
BATCH = 4
SEQ = 4096
DEPTH = 4
DEC_BATCH = 8
DEC_SEQ = 8192
PAST_LEN = 128

N_MIXERS = 2
N_A_LAYERS = (DEPTH + 1) // 2
N_B_LAYERS = DEPTH // 2
CHUNK = 128
GMLP_WIDTH = D_MODEL
GMLP_GROUPS = 8
GMLP_GROUP_DIM = GMLP_WIDTH // GMLP_GROUPS
DIFF_HEADS = 8
DIFF_HEAD_DIM = D_MODEL // (2 * DIFF_HEADS)
DIFF_V_DIM = 2 * DIFF_HEAD_DIM
D_FF = 2816
CONV_WIDTH = 3
ROPE_THETA = 10000.0
NORM_EPS = 1e-6
SUBLN_EPS = 1e-5
BLOCK_Q = 128

kernel_name = "hybrid_gmlp_diffattn_convffn_encoder"


def rmsnorm(x, g, eps=NORM_EPS):
    xf = x.astype(jnp.float32)
    y = xf * lax.rsqrt(jnp.mean(xf * xf, axis=-1, keepdims=True) + eps)
    return (y * g.astype(jnp.float32)).astype(x.dtype)


def rope(x):
    S, dh = x.shape[1], x.shape[-1]
    pos = jnp.arange(S, dtype=jnp.float32)
    inv_freq = ROPE_THETA ** (-jnp.arange(0, dh, 2, dtype=jnp.float32) / dh)
    ang = pos[:, None] * inv_freq[None, :]
    ang = jnp.concatenate([ang, ang], axis=-1)
    cos = jnp.cos(ang)[None, :, None, :].astype(x.dtype)
    sin = jnp.sin(ang)[None, :, None, :].astype(x.dtype)
    x1, x2 = jnp.split(x, 2, axis=-1)
    rot = jnp.concatenate([-x2, x1], axis=-1)
    return x * cos + rot * sin


def gmlp_mixer(h, w_in, v_gain, w_s, b_s, w_out):
    B, S, _ = h.shape
    z = jax.nn.gelu(h @ w_in)
    u, v = jnp.split(z, 2, axis=-1)
    v = rmsnorm(v, v_gain)
    v = v.reshape(B, S // CHUNK, CHUNK, GMLP_GROUPS, GMLP_GROUP_DIM)
    v = jnp.einsum('gpq,bcqgd->bcpgd', w_s, v) + b_s.T[None, None, :, :, None]
    y = u * v.reshape(B, S, GMLP_WIDTH)
    return y @ w_out


def diff_attention(h, w_qkv, lam_q1, lam_k1, lam_q2, lam_k2, subln_g, w_out, layer_idx):
    B, S, _ = h.shape
    H, dh = DIFF_HEADS, DIFF_HEAD_DIM
    q, k, v = jnp.split(h @ w_qkv, 3, axis=-1)
    q = rope(q.reshape(B, S, 2 * H, dh)).reshape(B, S, H, 2, dh)
    k = rope(k.reshape(B, S, 2 * H, dh)).reshape(B, S, H, 2, dh)
    v = v.reshape(B, S, H, DIFF_V_DIM)
    scale = dh ** -0.5
    lam_init = 0.8 - 0.6 * math.exp(-0.3 * layer_idx)
    f32 = jnp.float32
    lam = (jnp.exp(jnp.sum(lam_q1.astype(f32) * lam_k1.astype(f32)))
           - jnp.exp(jnp.sum(lam_q2.astype(f32) * lam_k2.astype(f32))) + lam_init)
    nb = S // BLOCK_Q
    qb = jnp.moveaxis(q.reshape(B, nb, BLOCK_Q, H, 2, dh), 1, 0)

    def block(qblk):
        s = jnp.einsum('bqhcd,bkhcd->bhcqk', qblk, k).astype(f32) * scale
        p = jax.nn.softmax(s, axis=-1)
        a = p[:, :, 0] - lam * p[:, :, 1]
        return jnp.einsum('bhqk,bkhe->bqhe', a.astype(v.dtype), v)

    o = lax.map(block, qb)
    o = jnp.moveaxis(o, 0, 1).reshape(B, S, H, DIFF_V_DIM)
    o = rmsnorm(o, subln_g, SUBLN_EPS) * (1.0 - lam_init)
    return o.reshape(B, S, H * DIFF_V_DIM) @ w_out


def conv_ffn(h, w_in, conv_w, conv_b, w_out):
    S = h.shape[1]
    a = h @ w_in
    half = CONV_WIDTH // 2
    ap = jnp.pad(a, ((0, 0), (half, half), (0, 0)))
    c = conv_b
    for t in range(CONV_WIDTH):
        c = c + ap[:, t:t + S] * conv_w[t]
    g, u = jnp.split(c, 2, axis=-1)
    return (jax.nn.silu(g) * u) @ w_out


def trunk(x, norm_mix, norm_ffn, norm_final,
          gmlp_w_in, gmlp_v_gain, gmlp_w_s, gmlp_b_s, gmlp_w_out,
          diff_w_qkv, diff_lam_q1, diff_lam_k1, diff_lam_q2, diff_lam_k2, diff_subln_g, diff_w_out,
          ffn_w_in, ffn_conv_w, ffn_conv_b, ffn_w_out):
    for i in range(DEPTH):
        h = rmsnorm(x, norm_mix[i])
        j = i // N_MIXERS
        if i % N_MIXERS == 0:
            x = x + gmlp_mixer(h, gmlp_w_in[j], gmlp_v_gain[j], gmlp_w_s[j], gmlp_b_s[j], gmlp_w_out[j])
        else:
            x = x + diff_attention(h, diff_w_qkv[j], diff_lam_q1[j], diff_lam_k1[j],
                                   diff_lam_q2[j], diff_lam_k2[j], diff_subln_g[j], diff_w_out[j], i)
        h = rmsnorm(x, norm_ffn[i])
        x = x + conv_ffn(h, ffn_w_in[i], ffn_conv_w[i], ffn_conv_b[i], ffn_w_out[i])
    return rmsnorm(x, norm_final)


def setup_inputs(seed: int = 0) -> dict:
    key = jax.random.key(seed)
    ks = jax.random.split(key, 24)
    f32 = jnp.float32
    nrm = lambda k, shape, s: (jax.random.normal(k, shape, f32) * s)
    res_scale = (2.0 * DEPTH) ** -0.5
    return {
        'x_prompt': nrm(ks[0], (BATCH, SEQ, D_MODEL), 1.0),
        'x_sample': nrm(ks[1], (DEC_BATCH, DEC_SEQ, D_MODEL), 1.0),
        'norm_mix': 1.0 + nrm(ks[2], (DEPTH, D_MODEL), 0.02),
        'norm_ffn': 1.0 + nrm(ks[3], (DEPTH, D_MODEL), 0.02),
        'norm_final': 1.0 + nrm(ks[4], (D_MODEL,), 0.02),
        'gmlp_w_in': nrm(ks[5], (N_A_LAYERS, D_MODEL, 2 * GMLP_WIDTH), D_MODEL ** -0.5),
        'gmlp_v_gain': 1.0 + nrm(ks[6], (N_A_LAYERS, GMLP_WIDTH), 0.02),
        'gmlp_w_s': nrm(ks[7], (N_A_LAYERS, GMLP_GROUPS, CHUNK, CHUNK), CHUNK ** -0.5),
        'gmlp_b_s': 1.0 + nrm(ks[8], (N_A_LAYERS, GMLP_GROUPS, CHUNK), 0.02),
        'gmlp_w_out': nrm(ks[9], (N_A_LAYERS, GMLP_WIDTH, D_MODEL), GMLP_WIDTH ** -0.5 * res_scale),
        'diff_w_qkv': nrm(ks[10], (N_B_LAYERS, D_MODEL, 3 * D_MODEL), D_MODEL ** -0.5),
        'diff_lam_q1': nrm(ks[11], (N_B_LAYERS, DIFF_HEAD_DIM), 0.1),
        'diff_lam_k1': nrm(ks[12], (N_B_LAYERS, DIFF_HEAD_DIM), 0.1),
        'diff_lam_q2': nrm(ks[13], (N_B_LAYERS, DIFF_HEAD_DIM), 0.1),
        'diff_lam_k2': nrm(ks[14], (N_B_LAYERS, DIFF_HEAD_DIM), 0.1),
        'diff_subln_g': 1.0 + nrm(ks[15], (N_B_LAYERS, DIFF_V_DIM), 0.02),
        'diff_w_out': nrm(ks[16], (N_B_LAYERS, D_MODEL, D_MODEL), D_MODEL ** -0.5 * res_scale),
        'ffn_w_in': nrm(ks[17], (DEPTH, D_MODEL, 2 * D_FF), D_MODEL ** -0.5),
        'ffn_conv_w': nrm(ks[18], (DEPTH, CONV_WIDTH, 2 * D_FF), CONV_WIDTH ** -0.5),
        'ffn_conv_b': nrm(ks[19], (DEPTH, 2 * D_FF), 0.01),
        'ffn_w_out': nrm(ks[20], (DEPTH, D_FF, D_MODEL), D_FF ** -0.5 * res_scale),
    }


def reference(x_prompt, x_sample, norm_mix, norm_ffn, norm_final,
              gmlp_w_in, gmlp_v_gain, gmlp_w_s, gmlp_b_s, gmlp_w_out,
              diff_w_qkv, diff_lam_q1, diff_lam_k1, diff_lam_q2, diff_lam_k2, diff_subln_g, diff_w_out,
              ffn_w_in, ffn_conv_w, ffn_conv_b, ffn_w_out):
    params = (norm_mix, norm_ffn, norm_final,
              gmlp_w_in, gmlp_v_gain, gmlp_w_s, gmlp_b_s, gmlp_w_out,
              diff_w_qkv, diff_lam_q1, diff_lam_k1, diff_lam_q2, diff_lam_k2, diff_subln_g, diff_w_out,
              ffn_w_in, ffn_conv_w, ffn_conv_b, ffn_w_out)
    y_prompt = trunk(x_prompt, *params)
    y_sample = trunk(x_sample, *params)
    return (y_prompt, y_sample)
```

```cpp
#include <hip/hip_runtime.h>
#include <hip/hip_cooperative_groups.h>
#include <cmath>
#include <cstdio>
namespace cg = cooperative_groups;

typedef unsigned short bf16_t;
typedef short bf16x8 __attribute__((ext_vector_type(8)));
typedef float f32x16 __attribute__((ext_vector_type(16)));
typedef float f32x4 __attribute__((ext_vector_type(4)));
typedef float f32x2 __attribute__((ext_vector_type(2)));
typedef unsigned u32x4 __attribute__((ext_vector_type(4)));
typedef unsigned u32x2 __attribute__((ext_vector_type(2)));
typedef __bf16 bf16x2_t __attribute__((ext_vector_type(2)));

#define DI __device__ __forceinline__
#define MFMA(a, b, c) __builtin_amdgcn_mfma_f32_32x32x16_bf16((a), (b), (c), 0, 0, 0)
#define MFMA16(a, b, c) __builtin_amdgcn_mfma_f32_16x16x32_bf16((a), (b), (c), 0, 0, 0)
typedef f32x4 gacc_t[8][4];

constexpr int T = 81920, TP = 16384, D = 1024, NTH = 512;
constexpr int XB_LDS_OFF = 256 * 528 + 1024;
constexpr int LDS_BYTES = 256 * 528 + 1024 + 16;

constexpr size_t OFF_GIN = 0;
constexpr size_t OFF_GOUT = OFF_GIN + 2ull * 2048 * 1024 * 2;
constexpr size_t OFF_GS = OFF_GOUT + 2ull * 1024 * 1024 * 2;
constexpr size_t OFF_QKV = OFF_GS + 2ull * 8 * 128 * 128 * 2;
constexpr size_t OFF_DOUT = OFF_QKV + 2ull * 3072 * 1024 * 2;
constexpr size_t OFF_FIN = OFF_DOUT + 2ull * 1024 * 1024 * 2;
constexpr size_t OFF_FOUT = OFF_FIN + 4ull * 5632 * 1024 * 2;
constexpr size_t OFF_ROPE = OFF_FOUT + 4ull * 1024 * 2816 * 2;
constexpr size_t OFF_H = OFF_ROPE + 8192ull * 32 * 8;
constexpr size_t OFF_BIG = OFF_H + (size_t)T * 1024 * 2;
constexpr size_t OFF_HALO = OFF_BIG + (size_t)T * 3072 * 2;
constexpr size_t OFF_H2 = OFF_HALO + 320ull * 4 * 5632 * 2;
constexpr size_t OFF_SSQ = OFF_H2 + (size_t)T * 1024 * 2;
constexpr size_t OFF_BAR = OFF_SSQ + (size_t)T * 4 * 4;
constexpr size_t WS_END = OFF_BAR + 3456 * 4;
constexpr int RSTD_OFF = 256 * 528;

struct Params {
    const float* in[21];
    float* out;
    char* ws;
    float inv_freq[32];
};

DI unsigned pk2(float a, float b) { f32x2 v = {a, b}; bf16x2_t r = __builtin_convertvector(v, bf16x2_t); return __builtin_bit_cast(unsigned, r); }
DI bf16_t bf1(float a) { return (bf16_t)(pk2(a, 0.f) & 0xffffu); }
DI float bflo(unsigned w) { return __uint_as_float(w << 16); }
DI float bfhi(unsigned w) { return __uint_as_float(w & 0xffff0000u); }
DI float wave_sum(float v) {
#pragma unroll
    for (int o = 1; o < 64; o <<= 1) v += __shfl_xor(v, o);
    return v;
}
DI int crow(int i, int h) { return (i & 3) + 8 * (i >> 2) + 4 * h; }
DI int swz(int row, int chunk) { return row * 128 + ((chunk ^ ((row >> 1) & 7)) << 4); }
DI bf16x8 ldfrag(const char* lds, int row, int chunk) { return *(const bf16x8*)(lds + swz(row, chunk)); }
DI bool is_seq_start(int R) { return R < TP ? (R & 4095) == 0 : ((R - TP) & 8191) == 0; }

#define GAS __attribute__((address_space(1)))
#define LAS __attribute__((address_space(3)))
template <bool RSTD>
DI void gemm_tile(gacc_t& acc, const bf16_t* __restrict__ A, int lda, const bf16_t* __restrict__ Bt, int ldb, int K,
                  char* lds, int tid, int wr, int wc, int lane, const float* ssq_row) {
#pragma unroll
    for (int m = 0; m < 8; ++m)
#pragma unroll
        for (int n = 0; n < 4; ++n)
#pragma unroll
            for (int j = 0; j < 4; ++j) acc[m][n][j] = 0.f;
    const int nk = K / 64;
    const int fr = lane & 15, fq = lane >> 4;
    const int srow = tid >> 3, sch = tid & 7;
    const int cl = sch ^ ((srow >> 1) & 7);
    const int wv = __builtin_amdgcn_readfirstlane(tid >> 6);
    const bf16_t* ap = A + (long)srow * lda + cl * 8;
    const bf16_t* bp = Bt + (long)srow * ldb + cl * 8;
    LAS char* l3 = (LAS char*)lds;
#define GEMM_ISSUE(KT, ST) do { \
        _Pragma("unroll") for (int i_ = 0; i_ < 4; ++i_) { \
            __builtin_amdgcn_global_load_lds((const GAS unsigned*)(ap + (long)(64 * i_) * lda + (KT) * 64), (LAS unsigned*)(l3 + (ST) * 65536 + i_ * 8192 + wv * 1024), 16, 0, 0); \
            __builtin_amdgcn_global_load_lds((const GAS unsigned*)(bp + (long)(64 * i_) * ldb + (KT) * 64), (LAS unsigned*)(l3 + (ST) * 65536 + 32768 + i_ * 8192 + wv * 1024), 16, 0, 0); \
        } } while (0)
    GEMM_ISSUE(0, 0);
    if (RSTD && tid < 256) {
        const f32x4 q = *(const f32x4*)ssq_row;
        ((float*)(lds + RSTD_OFF))[tid] = 1.0f / sqrtf(((q.x + q.y) + (q.z + q.w)) * (1.0f / 1024.0f) + 1e-6f);
    }
    asm volatile("s_waitcnt vmcnt(0)" ::: "memory");
    __syncthreads();
    for (int kt = 0; kt < nk; ++kt) {
        const char* cur = lds + (kt & 1) * 65536;
        if (kt + 1 < nk) GEMM_ISSUE(kt + 1, (kt + 1) & 1);
        bf16x8 bfr[2][4], afr[3];
#pragma unroll
        for (int n = 0; n < 4; ++n) bfr[0][n] = ldfrag(cur + 32768, wc * 64 + n * 16 + fr, fq);
        afr[0] = ldfrag(cur, wr * 128 + fr, fq);
        afr[1] = ldfrag(cur, wr * 128 + 16 + fr, fq);
#pragma unroll
        for (int idx = 0; idx < 16; ++idx) {
            const int ks = idx >> 3, m = idx & 7;
            if (idx < 14) afr[(idx + 2) % 3] = ldfrag(cur, wr * 128 + ((idx + 2) & 7) * 16 + fr, ((idx + 2) >> 3) * 4 + fq);
            if (ks == 0 && m >= 2 && m < 6) bfr[1][m - 2] = ldfrag(cur + 32768, wc * 64 + (m - 2) * 16 + fr, 4 + fq);
#pragma unroll
            for (int n = 0; n < 4; ++n) acc[m][n] = MFMA16(afr[idx % 3], bfr[ks][n], acc[m][n]);
        }
        __builtin_amdgcn_sched_group_barrier(0x100, 6, 0);
#define GEMM_SG1() do { __builtin_amdgcn_sched_group_barrier(0x100, 1, 0); __builtin_amdgcn_sched_group_barrier(0x008, 4, 0); } while (0)
#define GEMM_SG2() do { __builtin_amdgcn_sched_group_barrier(0x100, 2, 0); __builtin_amdgcn_sched_group_barrier(0x008, 4, 0); } while (0)
        GEMM_SG1(); GEMM_SG1(); GEMM_SG2(); GEMM_SG2(); GEMM_SG2(); GEMM_SG2(); GEMM_SG1(); GEMM_SG1();
        GEMM_SG1(); GEMM_SG1(); GEMM_SG1(); GEMM_SG1(); GEMM_SG1(); GEMM_SG1();
        __builtin_amdgcn_sched_group_barrier(0x008, 8, 0);
        __builtin_amdgcn_sched_barrier(0);
        asm volatile("s_waitcnt vmcnt(0)" ::: "memory");
        __syncthreads();
    }
}

DI bool tile_order(int L, int nM, int nN, int& pm, int& pn) {
    const int nwg = nM * nN;
    if (L >= nwg) return false;
    int wgid = L;
    { const int q = nwg / 8, r = nwg % 8, xcd = wgid % 8, off = wgid / 8; wgid = (xcd < r ? xcd * (q + 1) : r * (q + 1) + (xcd - r) * q) + off; }
    const int nig = 8 * nN, gid = wgid / nig, fm = gid * 8, gsz = (nM - fm) < 8 ? (nM - fm) : 8;
    pm = fm + ((wgid % nig) % gsz); pn = (wgid % nig) / gsz;
    return true;
}

DI void store_tile_from_lds(const char* lds, bf16_t* dst, long ld, int tid) {
#pragma unroll
    for (int k = 0; k < 16; ++k) {
        const int id = tid + NTH * k, row = id >> 5, ch = id & 31;
        const u32x4 v = *(const u32x4*)(lds + row * 528 + ch * 16);
        *(u32x4*)(dst + (long)row * ld + ch * 8) = v;
    }
}
struct EpiGelu {
    static constexpr bool NEEDS_RSTD = true;
    bf16_t* z;
    DI void operator()(gacc_t& acc, int pm, int pn, char* lds, int tid, int wr, int wc, int lane) const {
        asm volatile("" : "+v"(tid), "+v"(lane));
        const int fr = lane & 15, fq = lane >> 4;
        char* lbase = lds + (wr * 128 + 4 * fq) * 528 + (wc * 64 + fr) * 2;
        const float* rl = (const float*)(lds + RSTD_OFF) + wr * 128 + 4 * fq;
#pragma unroll
        for (int m = 0; m < 8; ++m)
#pragma unroll
            for (int n = 0; n < 4; ++n) {
#pragma unroll
                for (int j = 0; j < 4; ++j) {
                    const float x = acc[m][n][j] * rl[m * 16 + j];
                    const float u = 0.7978845608028654f * (x + 0.044715f * x * x * x);
                    const float e = __builtin_amdgcn_exp2f(-2.885390081777927f * u);
                    const float g = x * __builtin_amdgcn_rcpf(1.0f + e);
                    *(bf16_t*)(lbase + (m * 16 + j) * 528 + n * 32) = bf1(g);
                }
                __builtin_amdgcn_sched_barrier(0);
            }
        __syncthreads();
        store_tile_from_lds(lds, z + (long)pm * 256 * 2048 + pn * 256, 2048, tid);
        __syncthreads();
    }
};
struct EpiResid {
    static constexpr bool NEEDS_RSTD = false;
    const bf16_t* xold; bf16_t* xnew; float* ssq;
    DI void operator()(gacc_t& acc, int pm, int pn, char* lds, int tid, int wr, int wc, int lane) const {
        asm volatile("" : "+v"(tid), "+v"(lane));
        const int fr = lane & 15, fq = lane >> 4, wid = tid >> 6;
        char* lbase = lds + (wr * 128 + 4 * fq) * 528 + (wc * 64 + fr) * 2;
#pragma unroll
        for (int m = 0; m < 8; ++m)
#pragma unroll
            for (int n = 0; n < 4; ++n)
#pragma unroll
                for (int j = 0; j < 4; ++j) *(bf16_t*)(lbase + (m * 16 + j) * 528 + n * 32) = bf1(acc[m][n][j]);
        __builtin_amdgcn_sched_barrier(0);
        __syncthreads();
        __builtin_amdgcn_sched_barrier(0);
        const int g = lane >> 5, j32 = lane & 31;
#pragma unroll
        for (int ib = 0; ib < 4; ++ib) {
            __builtin_amdgcn_sched_barrier(0);
            u32x4 xv[4];
#pragma unroll
            for (int u = 0; u < 4; ++u) {
                const long row = (long)pm * 256 + (ib * 4 + u) * 16 + wid * 2 + g;
                xv[u] = *(const u32x4*)(xold + row * 1024 + pn * 256 + j32 * 8);
            }
#pragma unroll
            for (int u = 0; u < 4; ++u) {
                const int rloc = (ib * 4 + u) * 16 + wid * 2 + g;
                const long row = (long)pm * 256 + rloc;
                const u32x4 a = *(const u32x4*)(lds + rloc * 528 + j32 * 16);
                u32x4 w; float ss = 0.f;
#pragma unroll
                for (int e = 0; e < 4; ++e) {
                    w[e] = pk2(bflo(xv[u][e]) + bflo(a[e]), bfhi(xv[u][e]) + bfhi(a[e]));
                    const float b0 = bflo(w[e]), b1 = bfhi(w[e]);
                    ss += b0 * b0 + b1 * b1;
                }
                *(u32x4*)(xnew + row * 1024 + pn * 256 + j32 * 8) = w;
#pragma unroll
                for (int o = 1; o < 32; o <<= 1) ss += __shfl_xor(ss, o);
                if (j32 == 0) ssq[row * 4 + pn] = ss;
            }
        }
        __syncthreads();
    }
};
struct EpiQkv {
    static constexpr bool NEEDS_RSTD = true;
    bf16_t* qb; bf16_t* kb; bf16_t* vt; const f32x2* rope;
    DI void operator()(gacc_t& acc, int pm, int pn, char* lds, int tid, int wr, int wc, int lane) const {
        asm volatile("" : "+v"(tid), "+v"(lane));
        const int fr = lane & 15, fq = lane >> 4;
        const int col0 = pn * 256 + wc * 64;
        const int region = col0 >> 10, cr = col0 & 1023;
        const int R0 = pm * 256;
        const int t0 = R0 < TP ? (R0 & ~4095) : TP + ((R0 - TP) & ~8191);
        const int S = R0 < TP ? 4096 : 8192;
        const float* rl = (const float*)(lds + RSTD_OFF) + wr * 128 + 4 * fq;
        if (region < 2) {
            const float sc = region == 0 ? 0.18033688011112042f : 1.0f;
            char* lbase = lds + (wr * 128 + 4 * fq) * 528 + (wc * 64 + fr) * 2;
            const f32x2* rbase = rope + (R0 - t0 + wr * 128 + 4 * fq) * 32 + fr;
#pragma unroll
            for (int m = 0; m < 8; ++m) {
#pragma unroll
                for (int j = 0; j < 4; ++j) {
                    const int ro = m * 16 + j;
                    const float rs = rl[ro] * sc;
#pragma unroll
                    for (int n = 0; n < 2; ++n) {
                        const f32x2 cs = rbase[ro * 32 + n * 16];
                        const float x1 = acc[m][n][j], x2 = acc[m][n + 2][j];
                        const float o1 = (x1 * cs.x - x2 * cs.y) * rs, o2 = (x2 * cs.x + x1 * cs.y) * rs;
                        *(bf16_t*)(lbase + ro * 528 + n * 32) = bf1(o1); *(bf16_t*)(lbase + ro * 528 + n * 32 + 64) = bf1(o2);
                    }
                }
                __builtin_amdgcn_sched_barrier(0);
            }
        } else {
            const int head = cr >> 7;
            const int kbase = (R0 - t0) + wr * 128 + 8 * (fq & 1) + 4 * (fq >> 1);
#pragma unroll
            for (int n = 0; n < 4; ++n) {
                const int e = (cr & 127) + n * 16 + fr;
                bf16_t* vrow = vt + (long)t0 * 1024 + (long)(head * 128 + e) * S + kbase;
#pragma unroll
                for (int m = 0; m < 8; ++m) {
                    const float* rq = rl + m * 16;
                    u32x2 w;
                    w.x = pk2(acc[m][n][0] * rq[0], acc[m][n][1] * rq[1]); w.y = pk2(acc[m][n][2] * rq[2], acc[m][n][3] * rq[3]);
                    *(u32x2*)(vrow + (m >> 1) * 32 + 16 * (m & 1)) = w;
                }
                __builtin_amdgcn_sched_barrier(0);
            }
        }
        if (pn < 8) {
            __syncthreads();
            store_tile_from_lds(lds, (pn < 4 ? qb : kb) + (long)R0 * 1024 + (pn & 3) * 256, 1024, tid);
            __syncthreads();
        }
    }
};
struct EpiFfn {
    static constexpr bool NEEDS_RSTD = true;
    const float* cw; const float* cb; bf16_t* act; bf16_t* halo;
    DI void operator()(gacc_t& acc, int pm, int pn, char* lds, int tid, int wr, int wc, int lane) const {
        asm volatile("" : "+v"(tid), "+v"(lane));
        const int fr = lane & 15, fq = lane >> 4;
        constexpr int RS = 528;
        const float* rl = (const float*)(lds + RSTD_OFF) + wr * 128 + 4 * fq;
        {
            char* lbase = lds + (wr * 128 + 4 * fq) * RS + (wc * 64 + fr) * 2;
#pragma unroll
            for (int m = 0; m < 8; ++m)
#pragma unroll
                for (int n = 0; n < 4; ++n)
#pragma unroll
                    for (int j = 0; j < 4; ++j) *(bf16_t*)(lbase + (m * 16 + j) * RS + n * 32) = bf1(acc[m][n][j] * rl[m * 16 + j]);
        }
        {
            bf16_t* hrow = halo + (long)(pm * 4) * 5632 + pn * 256 + wc * 64 + fr;
            if (wr == 0 && fq == 0) {
#pragma unroll
                for (int n = 0; n < 4; ++n) { hrow[n * 16] = bf1(acc[0][n][0] * rl[0]); hrow[5632 + n * 16] = bf1(acc[0][n][1] * rl[1]); }
            }
            if (wr == 1 && fq == 3) {
#pragma unroll
                for (int n = 0; n < 4; ++n) { hrow[2 * 5632 + n * 16] = bf1(acc[7][n][2] * rl[7 * 16 + 2]); hrow[3 * 5632 + n * 16] = bf1(acc[7][n][3] * rl[7 * 16 + 3]); }
            }
        }
        __syncthreads();
        const int cgp = tid & 15, rs = tid >> 4;
        const int jg = pn * 128 + cgp * 8;
        float wg[3][8], wu[3][8], bg[8], bu[8];
#pragma unroll
        for (int t = 0; t < 3; ++t) {
            const f32x4 a0 = *(const f32x4*)(cw + t * 5632 + jg), a1 = *(const f32x4*)(cw + t * 5632 + jg + 4);
            const f32x4 b0 = *(const f32x4*)(cw + t * 5632 + 2816 + jg), b1 = *(const f32x4*)(cw + t * 5632 + 2816 + jg + 4);
#pragma unroll
            for (int e = 0; e < 4; ++e) { wg[t][e] = a0[e]; wg[t][4 + e] = a1[e]; wu[t][e] = b0[e]; wu[t][4 + e] = b1[e]; }
        }
        {
            const f32x4 a0 = *(const f32x4*)(cb + jg), a1 = *(const f32x4*)(cb + jg + 4);
            const f32x4 b0 = *(const f32x4*)(cb + 2816 + jg), b1 = *(const f32x4*)(cb + 2816 + jg + 4);
#pragma unroll
            for (int e = 0; e < 4; ++e) { bg[e] = a0[e]; bg[4 + e] = a1[e]; bu[e] = b0[e]; bu[4 + e] = b1[e]; }
        }
        const char* gbase = lds + ((cgp >> 2) * 64 + (cgp & 3) * 8) * 2;
        const int R0 = pm * 256;
        const bool first = is_seq_start(R0), last = is_seq_start(R0 + 256);
        float pg[8], pu[8], cg_[8], cu[8];
        const int r0 = rs * 8;
        auto ldrow = [&](int row, float (&g)[8], float (&u)[8]) {
            if (row < 0 || row > 255) {
#pragma unroll
                for (int e = 0; e < 8; ++e) { g[e] = 0.f; u[e] = 0.f; }
            } else {
                const u32x4 a = *(const u32x4*)(gbase + row * RS), b = *(const u32x4*)(gbase + row * RS + 64);
                g[0] = bflo(a.x); g[1] = bfhi(a.x); g[2] = bflo(a.y); g[3] = bfhi(a.y); g[4] = bflo(a.z); g[5] = bfhi(a.z); g[6] = bflo(a.w); g[7] = bfhi(a.w);
                u[0] = bflo(b.x); u[1] = bfhi(b.x); u[2] = bflo(b.y); u[3] = bfhi(b.y); u[4] = bflo(b.z); u[5] = bfhi(b.z); u[6] = bflo(b.w); u[7] = bfhi(b.w);
            }
        };
        ldrow(r0 - 1, pg, pu);
        ldrow(r0, cg_, cu);
#pragma unroll
        for (int rr = 0; rr < 8; ++rr) {
            const int row = r0 + rr;
            float ng[8], nu[8];
            ldrow(row + 1, ng, nu);
            float o[8];
#pragma unroll
            for (int e = 0; e < 8; ++e) {
                const float g = bg[e] + wg[0][e] * pg[e] + wg[1][e] * cg_[e] + wg[2][e] * ng[e];
                const float u = bu[e] + wu[0][e] * pu[e] + wu[1][e] * cu[e] + wu[2][e] * nu[e];
                const float sg = g * __builtin_amdgcn_rcpf(1.0f + __builtin_amdgcn_exp2f(-1.4426950408889634f * g));
                o[e] = sg * u;
            }
            const bool skip = (row == 0 && !first) || (row == 255 && !last);
            if (!skip) {
                u32x4 w; w.x = pk2(o[0], o[1]); w.y = pk2(o[2], o[3]); w.z = pk2(o[4], o[5]); w.w = pk2(o[6], o[7]);
                *(u32x4*)(act + (long)(R0 + row) * 2816 + jg) = w;
            }
#pragma unroll
            for (int e = 0; e < 8; ++e) { pg[e] = cg_[e]; pu[e] = cu[e]; cg_[e] = ng[e]; cu[e] = nu[e]; }
        }
        __syncthreads();
    }
};

template <class Epi>
DI void gemm_phase(const bf16_t* A, int lda, const bf16_t* Bt, int ldb, int N, int K, const Epi& epi, const float* ssq, char* lds, int tid) {
    asm volatile("" : "+v"(tid));
    const int wid = tid >> 6, lane = tid & 63, wr = wid >> 2, wc = wid & 3;
    const int nM = T / 256, nN = N / 256;
    for (int it = 0;; ++it) {
        int pm, pn;
        if (!tile_order(it * (int)gridDim.x + (int)blockIdx.x, nM, nN, pm, pn)) break;
        if (Epi::NEEDS_RSTD) __syncthreads();
        gacc_t acc;
        gemm_tile<Epi::NEEDS_RSTD>(acc, A + (long)pm * 256 * lda, lda, Bt + (long)pn * 256 * ldb, ldb, K, lds, tid, wr, wc, lane, ssq + (long)(pm * 256 + (tid & 255)) * 4);
        epi(acc, pm, pn, lds, tid, wr, wc, lane);
    }
}

DI void convert_T(const float* __restrict__ W, int K, int N, bf16_t* __restrict__ Wt, bool permute, const float* __restrict__ gain, char* lds, int tid) {
    asm volatile("" : "+v"(tid));
    float* tile = (float*)lds;
    const int nnb = N / 64, ntiles = (K / 64) * nnb;
    for (int it = blockIdx.x; it < ntiles; it += gridDim.x) {
        const int k0 = (it / nnb) * 64, n0 = (it % nnb) * 64;
#pragma unroll
        for (int i = 0; i < 8; ++i) { const int idx = tid + NTH * i, kr = idx >> 6, nc = idx & 63; tile[kr * 65 + nc] = W[(long)(k0 + kr) * N + n0 + nc]; }
        __syncthreads();
#pragma unroll
        for (int i = 0; i < 8; ++i) {
            const int idx = tid + NTH * i, nr = idx >> 6, kc = idx & 63; const int n = n0 + nr; int nd = n;
            if (permute) { if (n < 2816) nd = (n >> 5) * 64 + (n & 31); else { const int j = n - 2816; nd = (j >> 5) * 64 + 32 + (j & 31); } }
            Wt[(long)nd * K + k0 + kc] = bf1(tile[kc * 65 + nr] * (gain ? gain[k0 + kc] : 1.0f));
        }
        __syncthreads();
    }
}

template <bool FINAL>
DI void norm_rows(const float* src0, const float* src1, const float* __restrict__ g, bf16_t* dst, float* fdst, float* copy, int wid, int lane) {
    asm volatile("" : "+v"(wid), "+v"(lane));
    for (int row = blockIdx.x * 8 + wid; row < T; row += gridDim.x * 8) {
        const float* xr = row < TP ? src0 + (long)row * 1024 : src1 + (long)(row - TP) * 1024;
        f32x4 v[4]; float ss = 0.f;
#pragma unroll
        for (int j = 0; j < 4; ++j) { v[j] = ((const f32x4*)xr)[lane + 64 * j]; ss += (v[j].x * v[j].x + v[j].y * v[j].y) + (v[j].z * v[j].z + v[j].w * v[j].w); }
        ss = wave_sum(ss);
        const float rstd = 1.0f / sqrtf(ss * (1.0f / 1024.0f) + 1e-6f);
#pragma unroll
        for (int j = 0; j < 4; ++j) {
            if (copy) ((f32x4*)(copy + (long)row * 1024))[lane + 64 * j] = v[j];
            const f32x4 gg = ((const f32x4*)g)[lane + 64 * j];
            const f32x4 o = v[j] * rstd * gg;
            if (FINAL) ((f32x4*)(fdst + (long)row * 1024))[lane + 64 * j] = o;
            else { u32x2 w; w.x = pk2(o.x, o.y); w.y = pk2(o.z, o.w); ((u32x2*)(dst + (long)row * 1024))[lane + 64 * j] = w; }
        }
    }
}

DI void final_norm(const bf16_t* __restrict__ xb, const float* __restrict__ g, float* __restrict__ out, int wid, int lane) {
    asm volatile("" : "+v"(wid), "+v"(lane));
    for (int row = blockIdx.x * 8 + wid; row < T; row += gridDim.x * 8) {
        const u32x4 a = *(const u32x4*)(xb + (long)row * 1024 + lane * 16), b = *(const u32x4*)(xb + (long)row * 1024 + lane * 16 + 8);
        float v[16];
#pragma unroll
        for (int e = 0; e < 4; ++e) { v[2 * e] = bflo(a[e]); v[2 * e + 1] = bfhi(a[e]); v[8 + 2 * e] = bflo(b[e]); v[8 + 2 * e + 1] = bfhi(b[e]); }
        float ss = 0.f;
#pragma unroll
        for (int e = 0; e < 16; ++e) ss += v[e] * v[e];
        ss = wave_sum(ss);
        const float rstd = 1.0f / sqrtf(ss * (1.0f / 1024.0f) + 1e-6f);
#pragma unroll
        for (int q = 0; q < 4; ++q) {
            const f32x4 gg = *(const f32x4*)(g + lane * 16 + q * 4);
            f32x4 o; o.x = v[4 * q] * rstd * gg.x; o.y = v[4 * q + 1] * rstd * gg.y; o.z = v[4 * q + 2] * rstd * gg.z; o.w = v[4 * q + 3] * rstd * gg.w;
            *(f32x4*)(out + (long)row * 1024 + lane * 16 + q * 4) = o;
        }
    }
}

DI void spatial_phase(const bf16_t* __restrict__ z, const bf16_t* __restrict__ wsb, const float* __restrict__ vgain, const float* __restrict__ bs,
                      bf16_t* __restrict__ y, char* lds, int tid, int wid, int lane) {
    float* srstd = (float*)(lds + 65536);
    char* la = lds; char* lb = lds + 32768;
    for (int unit = blockIdx.x; unit < T / 64; unit += gridDim.x) {
        asm volatile("" : "+v"(tid)); wid = tid >> 6; lane = tid & 63;
        const int l31 = lane & 31, hh = lane >> 5;
        const int wr = wid >> 1, wc = wid & 1;
        const long t0 = (long)(unit >> 1) * 128;
        const int g0 = (unit & 1) * 4;
#pragma unroll
        for (int rb = 0; rb < 4; ++rb) {
            u32x4 va[4], vb[4];
#pragma unroll
            for (int r = 0; r < 4; ++r) {
                const bf16_t* vr = z + (t0 + wid * 16 + rb * 4 + r) * 2048 + 1024 + lane * 16;
                va[r] = *(const u32x4*)vr; vb[r] = *(const u32x4*)(vr + 8);
            }
#pragma unroll
            for (int r = 0; r < 4; ++r) {
                float ss = 0.f;
#pragma unroll
                for (int e = 0; e < 4; ++e) { const float x0 = bflo(va[r][e]), x1 = bfhi(va[r][e]), x2 = bflo(vb[r][e]), x3 = bfhi(vb[r][e]); ss += (x0 * x0 + x1 * x1) + (x2 * x2 + x3 * x3); }
                ss = wave_sum(ss);
                if (lane == 0) srstd[wid * 16 + rb * 4 + r] = 1.0f / sqrtf(ss * (1.0f / 1024.0f) + 1e-6f);
            }
        }
        __syncthreads();
        for (int g = g0; g < g0 + 4; ++g) {
#pragma unroll
            for (int i = 0; i < 4; ++i) {
                const int id = tid + NTH * i, row = id >> 4, ch = id & 15;
                const u32x4 w = *(const u32x4*)(wsb + (long)(g * 128 + row) * 128 + ch * 8);
                *(u32x4*)(la + (ch >> 3) * 16384 + swz(row, ch & 7)) = w;
                const int q = row, d0 = ch * 8;
                const u32x4 vv = *(const u32x4*)(z + (t0 + q) * 2048 + 1024 + g * 128 + d0);
                const float rsq = srstd[q];
                const f32x4 g0 = *(const f32x4*)(vgain + g * 128 + d0), g1 = *(const f32x4*)(vgain + g * 128 + d0 + 4);
                float vals[8];
                vals[0] = bflo(vv.x) * rsq * g0.x; vals[1] = bfhi(vv.x) * rsq * g0.y; vals[2] = bflo(vv.y) * rsq * g0.z; vals[3] = bfhi(vv.y) * rsq * g0.w;
                vals[4] = bflo(vv.z) * rsq * g1.x; vals[5] = bfhi(vv.z) * rsq * g1.y; vals[6] = bflo(vv.w) * rsq * g1.z; vals[7] = bfhi(vv.w) * rsq * g1.w;
                char* dstb = lb + (q >> 6) * 16384 + (q & 7) * 2;
                const int qc = (q & 63) >> 3;
#pragma unroll
                for (int e = 0; e < 8; ++e) *(bf16_t*)(dstb + swz(d0 + e, qc)) = bf1(vals[e]);
            }
            __syncthreads();
            f32x16 acc[2];
#pragma unroll
            for (int n = 0; n < 2; ++n)
#pragma unroll
                for (int i = 0; i < 16; ++i) acc[n][i] = 0.f;
#pragma unroll
            for (int kh = 0; kh < 2; ++kh)
#pragma unroll
                for (int s = 0; s < 4; ++s) {
                    const bf16x8 af = ldfrag(la + kh * 16384, wr * 32 + l31, 2 * s + hh);
#pragma unroll
                    for (int n = 0; n < 2; ++n) { const bf16x8 bfr = ldfrag(lb + kh * 16384, wc * 64 + n * 32 + l31, 2 * s + hh); acc[n] = MFMA(af, bfr, acc[n]); }
                }
#pragma unroll
            for (int n = 0; n < 2; ++n)
#pragma unroll
                for (int i = 0; i < 16; ++i) {
                    const int p = wr * 32 + crow(i, hh), d = wc * 64 + n * 32 + l31;
                    const float val = acc[n][i] + bs[g * 128 + p];
                    const float uu = bflo((unsigned)z[(t0 + p) * 2048 + g * 128 + d]);
                    y[(t0 + p) * 1024 + g * 128 + d] = bf1(uu * val);
                }
            __syncthreads();
        }
    }
}

DI void attn_phase(const bf16_t* __restrict__ qb, const bf16_t* __restrict__ kb, const bf16_t* __restrict__ vt, bf16_t* __restrict__ ob,
                   const float* lq1, const float* lk1, const float* lq2, const float* lk2, const float* __restrict__ subg, float lam_init,
                   char* lds, int tid, int wid, int lane) {
    asm volatile("" : "+v"(tid)); wid = tid >> 6; lane = tid & 63;
    const int c = wid & 1, qs = wid >> 1, l31 = lane & 31, hh = lane >> 5;
    const float d1 = wave_sum(lq1[lane] * lk1[lane]), d2 = wave_sum(lq2[lane] * lk2[lane]);
    const float lam = expf(d1) - expf(d2) + lam_init;
    const int srow = tid >> 3, sch = tid & 7;
    const int wv = __builtin_amdgcn_readfirstlane(tid >> 6);
    LAS char* l3 = (LAS char*)lds;
    for (int u = blockIdx.x; u < 5120; u += gridDim.x) {
        int seq, head, qblk;
        if (u < 4096) { const int r = u >> 8, b = u & 255, x = b & 7, lb = b >> 3, p = (r >> 1) * 8 + x; seq = 4 + (p >> 3); head = p & 7; qblk = (r & 1) * 32 + lb; }
        else { const int v = u - 4096, r = v >> 8, b = v & 255, x = b & 7, lb = b >> 3, p = r * 8 + x; seq = p >> 3; head = p & 7; qblk = lb; }
        const int S = seq < 4 ? 4096 : 8192;
        const long t0 = seq < 4 ? (long)seq * 4096 : (long)TP + (long)(seq - 4) * 8192;
        const long qrow_t = t0 + qblk * 128 + qs * 32 + l31;
        bf16x8 qf[4];
        {
            const bf16_t* qrow = qb + qrow_t * 1024 + (head * 2 + c) * 64 + 8 * hh;
#pragma unroll
            for (int s = 0; s < 4; ++s) qf[s] = *(const bf16x8*)(qrow + 16 * s);
        }
        const int cl = sch ^ ((srow >> 1) & 7);
        const bf16_t* kp = kb + (t0 + srow) * 1024 + head * 128 + cl * 8;
        const bf16_t* vp = vt + t0 * 1024 + ((long)head * 128 + srow) * S + cl * 8;
        const int nkt = S / 64;
#define ATT_ISSUE(KT, ST) do { const int kt_ = (KT) < nkt ? (KT) : nkt - 1; LAS char* st_ = l3 + (ST) * 32768 + wv * 1024; \
            const bf16_t* kq_ = kp + (long)kt_ * 64 * 1024; const bf16_t* vq_ = vp + kt_ * 64; \
            __builtin_amdgcn_global_load_lds((const GAS unsigned*)kq_, (LAS unsigned*)st_, 16, 0, 0); \
            __builtin_amdgcn_global_load_lds((const GAS unsigned*)(kq_ + 64), (LAS unsigned*)(st_ + 8192), 16, 0, 0); \
            __builtin_amdgcn_global_load_lds((const GAS unsigned*)vq_, (LAS unsigned*)(st_ + 16384), 16, 0, 0); \
            __builtin_amdgcn_global_load_lds((const GAS unsigned*)(vq_ + (long)64 * S), (LAS unsigned*)(st_ + 24576), 16, 0, 0); } while (0)
        ATT_ISSUE(0, 0); ATT_ISSUE(1, 1); ATT_ISSUE(2, 2);
        f32x16 oacc[4];
#pragma unroll
        for (int ef = 0; ef < 4; ++ef)
#pragma unroll
            for (int i = 0; i < 16; ++i) oacc[ef][i] = 0.f;
        float l_run = 0.f;
        f32x16 negm;
#pragma unroll
        for (int i = 0; i < 16; ++i) negm[i] = 0.f;
        for (int kt = 0; kt < nkt; ++kt) {
            asm volatile("s_waitcnt vmcnt(8)" ::: "memory");
            asm volatile("s_waitcnt lgkmcnt(0)" ::: "memory"); __builtin_amdgcn_s_barrier();
            ATT_ISSUE(kt + 3, (kt + 3) & 3);
            const char* cur = lds + (kt & 3) * 32768;
            const char* kl = cur + c * 8192; const char* vl = cur + 16384;
            f32x16 sacc[2];
            {
                bf16x8 kfr[2][4];
#pragma unroll
                for (int kf = 0; kf < 2; ++kf)
#pragma unroll
                    for (int s = 0; s < 4; ++s) kfr[kf][s] = ldfrag(kl, kf * 32 + l31, 2 * s + hh);
#pragma unroll
                for (int kf = 0; kf < 2; ++kf) {
                    sacc[kf] = MFMA(kfr[kf][0], qf[0], negm);
#pragma unroll
                    for (int s = 1; s < 4; ++s) sacc[kf] = MFMA(kfr[kf][s], qf[s], sacc[kf]);
                }
            }
            bf16x8 vf[2][4];
#pragma unroll
            for (int ef = 0; ef < 4; ++ef) vf[0][ef] = ldfrag(vl, ef * 32 + l31, hh);
            __builtin_amdgcn_sched_group_barrier(0x100, 4, 0);
#pragma unroll
            for (int g_ = 0; g_ < 4; ++g_) { __builtin_amdgcn_sched_group_barrier(0x008, 1, 0); __builtin_amdgcn_sched_group_barrier(0x100, 1, 0); }
            __builtin_amdgcn_sched_group_barrier(0x008, 4, 0);
            __builtin_amdgcn_sched_group_barrier(0x100, 4, 0);
            float mx = fmaxf(fmaxf(sacc[0][0], sacc[0][1]), sacc[0][2]);
#pragma unroll
            for (int i = 3; i < 15; i += 2) mx = fmaxf(fmaxf(mx, sacc[0][i]), sacc[0][i + 1]);
            mx = fmaxf(fmaxf(mx, sacc[0][15]), sacc[1][0]);
#pragma unroll
            for (int i = 1; i < 15; i += 2) mx = fmaxf(fmaxf(mx, sacc[1][i]), sacc[1][i + 1]);
            mx = fmaxf(mx, sacc[1][15]);
            if (kt == 0 || __any(mx > 8.0f)) {
                const float mfull = fmaxf(mx, __shfl_xor(mx, 32));
                const float delta = kt == 0 ? mfull : fmaxf(mfull, 0.f);
                const float alpha = kt == 0 ? 1.0f : __builtin_amdgcn_exp2f(-delta);
                l_run *= alpha;
#pragma unroll
                for (int ef = 0; ef < 4; ++ef)
#pragma unroll
                    for (int i = 0; i < 16; ++i) oacc[ef][i] *= alpha;
#pragma unroll
                for (int i = 0; i < 16; ++i) { negm[i] -= delta; sacc[0][i] -= delta; sacc[1][i] -= delta; }
            }
            float ps = 0.f;
            bf16x8 pq[4];
#define ATT_SOFTQ(Q) do { const int kf_ = (Q) >> 1, s2_ = (Q) & 1; \
                _Pragma("unroll") for (int i = 0; i < 8; ++i) { const float p_ = __builtin_amdgcn_exp2f(sacc[kf_][8 * s2_ + i]); ps += p_; sacc[kf_][8 * s2_ + i] = p_; } \
                u32x4 w_; w_.x = pk2(sacc[kf_][8 * s2_ + 0], sacc[kf_][8 * s2_ + 1]); w_.y = pk2(sacc[kf_][8 * s2_ + 2], sacc[kf_][8 * s2_ + 3]); \
                w_.z = pk2(sacc[kf_][8 * s2_ + 4], sacc[kf_][8 * s2_ + 5]); w_.w = pk2(sacc[kf_][8 * s2_ + 6], sacc[kf_][8 * s2_ + 7]); \
                pq[Q] = __builtin_bit_cast(bf16x8, w_); } while (0)
            ATT_SOFTQ(0);
#pragma unroll
            for (int q = 0; q < 4; ++q) {
                if (q < 3) {
#pragma unroll
                    for (int ef = 0; ef < 4; ++ef) vf[(q + 1) & 1][ef] = ldfrag(vl, ef * 32 + l31, ((q + 1) >> 1) * 4 + 2 * ((q + 1) & 1) + hh);
                    if (q == 0) ATT_SOFTQ(1); else if (q == 1) ATT_SOFTQ(2); else ATT_SOFTQ(3);
                }
#pragma unroll
                for (int ef = 0; ef < 4; ++ef) oacc[ef] = MFMA(vf[q & 1][ef], pq[q], oacc[ef]);
            }
            l_run += ps;
            __builtin_amdgcn_sched_group_barrier(0x002, 20, 0);
#pragma unroll
            for (int g_ = 0; g_ < 12; ++g_) { __builtin_amdgcn_sched_group_barrier(0x008, 1, 0); __builtin_amdgcn_sched_group_barrier(0x100, 1, 0); __builtin_amdgcn_sched_group_barrier(0x002, 5, 0); }
            __builtin_amdgcn_sched_group_barrier(0x008, 4, 0);
        }
        asm volatile("s_waitcnt vmcnt(0)" ::: "memory");
        __syncthreads();
        const float lt = l_run + __shfl_xor(l_run, 32);
        const float inv = 1.0f / lt;
        float* xch = (float*)lds;
        if (c == 1) {
#pragma unroll
            for (int ef = 0; ef < 4; ++ef)
#pragma unroll
                for (int i = 0; i < 16; ++i) xch[((qs * 4 + ef) * 16 + i) * 64 + lane] = oacc[ef][i] * inv;
        }
        __syncthreads();
        if (c == 0) {
            float ss = 0.f;
#pragma unroll
            for (int ef = 0; ef < 4; ++ef)
#pragma unroll
                for (int i = 0; i < 16; ++i) { const float o = oacc[ef][i] * inv - lam * xch[((qs * 4 + ef) * 16 + i) * 64 + lane]; oacc[ef][i] = o; ss += o * o; }
            ss += __shfl_xor(ss, 32);
            const float rstd = (1.0f - lam_init) / sqrtf(ss * (1.0f / 128.0f) + 1e-5f);
            bf16_t* orow = ob + qrow_t * 1024 + head * 128;
#pragma unroll
            for (int ef = 0; ef < 4; ++ef)
#pragma unroll
                for (int g4 = 0; g4 < 4; ++g4) {
                    const int e = ef * 32 + 8 * g4 + 4 * hh;
                    const f32x4 gv = *(const f32x4*)(subg + e);
                    u32x2 w;
                    w.x = pk2(oacc[ef][4 * g4 + 0] * rstd * gv.x, oacc[ef][4 * g4 + 1] * rstd * gv.y);
                    w.y = pk2(oacc[ef][4 * g4 + 2] * rstd * gv.z, oacc[ef][4 * g4 + 3] * rstd * gv.w);
                    *(u32x2*)(orow + e) = w;
                }
        }
        __syncthreads();
    }
}

DI void unpack8(const u32x4 a, float (&f)[8]) {
    f[0] = bflo(a.x); f[1] = bfhi(a.x); f[2] = bflo(a.y); f[3] = bfhi(a.y); f[4] = bflo(a.z); f[5] = bfhi(a.z); f[6] = bflo(a.w); f[7] = bfhi(a.w);
}
DI void ffn_fixup(const bf16_t* halo, const float* cw, const float* cb, bf16_t* act, int tid) {
    asm volatile("" : "+v"(tid));
    const int total = 319 * 2 * 352;
    for (int idx = blockIdx.x * NTH + tid; idx < total; idx += gridDim.x * NTH) {
        const int b = idx / 704, rem = idx - b * 704, which = rem >= 352 ? 1 : 0, jc = rem - which * 352;
        const int R0 = (b + 1) * 256;
        if (is_seq_start(R0)) continue;
        const int j0 = jc * 8;
        const int ng = (j0 >> 5) * 64 + (j0 & 31);
        const bf16_t* hp = halo + (long)(b * 4 + 2 + which) * 5632 + ng;
        float g[3][8], u[3][8];
#pragma unroll
        for (int t = 0; t < 3; ++t) {
            unpack8(*(const u32x4*)(hp + (long)t * 5632), g[t]);
            unpack8(*(const u32x4*)(hp + (long)t * 5632 + 32), u[t]);
        }
        float o[8];
#pragma unroll
        for (int e = 0; e < 8; ++e) {
            const int j = j0 + e;
            const float gg = cb[j] + cw[j] * g[0][e] + cw[5632 + j] * g[1][e] + cw[2 * 5632 + j] * g[2][e];
            const float uu = cb[2816 + j] + cw[2816 + j] * u[0][e] + cw[5632 + 2816 + j] * u[1][e] + cw[2 * 5632 + 2816 + j] * u[2][e];
            o[e] = gg * __builtin_amdgcn_rcpf(1.0f + __builtin_amdgcn_exp2f(-1.4426950408889634f * gg)) * uu;
        }
        u32x4 w; w.x = pk2(o[0], o[1]); w.y = pk2(o[2], o[3]); w.z = pk2(o[4], o[5]); w.w = pk2(o[6], o[7]);
        *(u32x4*)(act + (long)(R0 - 1 + which) * 2816 + j0) = w;
    }
}

DI float dot8(const u32x4 a, const u32x4 b) {
    float s = 0.f;
#pragma unroll
    for (int e = 0; e < 4; ++e) s += bflo(a[e]) * bflo(b[e]) + bfhi(a[e]) * bfhi(b[e]);
    return s;
}
DI void ffn_fixup2(const bf16_t* __restrict__ hb, const bf16_t* __restrict__ wfin, const float* __restrict__ cw, const float* __restrict__ cb, bf16_t* __restrict__ act, int tid) {
    asm volatile("" : "+v"(tid));
    const int total = 319 * 2 * 2816;
    for (int idx = blockIdx.x * NTH + tid; idx < total; idx += gridDim.x * NTH) {
        const int b = idx / 5632, rem = idx % 5632, which = rem / 2816, j = rem % 2816;
        const int R0 = (b + 1) * 256;
        if (is_seq_start(R0)) continue;
        const int ng = (j >> 5) * 64 + (j & 31), nu = ng + 32;
        const int r = R0 - 1 + which;
        const bf16_t* h0 = hb + (long)(r - 1) * 1024; const bf16_t* h1 = h0 + 1024; const bf16_t* h2 = h1 + 1024;
        const bf16_t* wgp = wfin + (long)ng * 1024; const bf16_t* wup = wfin + (long)nu * 1024;
        float ag0 = 0.f, ag1 = 0.f, ag2 = 0.f, au0 = 0.f, au1 = 0.f, au2 = 0.f;
        for (int k = 0; k < 1024; k += 8) {
            const u32x4 x0 = *(const u32x4*)(h0 + k), x1 = *(const u32x4*)(h1 + k), x2 = *(const u32x4*)(h2 + k);
            const u32x4 g8 = *(const u32x4*)(wgp + k), u8 = *(const u32x4*)(wup + k);
            ag0 += dot8(x0, g8); ag1 += dot8(x1, g8); ag2 += dot8(x2, g8);
            au0 += dot8(x0, u8); au1 += dot8(x1, u8); au2 += dot8(x2, u8);
        }
        const float g = cb[j] + cw[j] * ag0 + cw[5632 + j] * ag1 + cw[2 * 5632 + j] * ag2;
        const float u = cb[2816 + j] + cw[2816 + j] * au0 + cw[5632 + 2816 + j] * au1 + cw[2 * 5632 + 2816 + j] * au2;
        const float sg = g * __builtin_amdgcn_rcpf(1.0f + __builtin_amdgcn_exp2f(-1.4426950408889634f * g));
        act[(long)r * 2816 + j] = bf1(sg * u);
    }
}


#define XB_TMO      128
#define XB_XCNT(j)  (256  + 64 * (j))
#define XB_XSUB(j)  (1280 + 64 * (j))
#define XB_XGEN(j)  (2304 + 64 * (j))
#define XB_TOP      3328
#define XB_TOPGEN   3392
#define XCD_BAR_WORDS 3456
#define XB_SPIN_CAP (1u << 18)
DI unsigned xb_ld(unsigned* p)              { return __hip_atomic_load(p, __ATOMIC_RELAXED, __HIP_MEMORY_SCOPE_AGENT); }
DI unsigned xb_add(unsigned* p, unsigned v) { return __hip_atomic_fetch_add(p, v, __ATOMIC_RELAXED, __HIP_MEMORY_SCOPE_AGENT); }
DI unsigned xb_xcc_id() { return (unsigned)__builtin_amdgcn_s_getreg((3 << 11) | 20) & 0xFu; }
#define XB_SPIN(cond, bar) do { unsigned _sp = 0; while (cond) { __builtin_amdgcn_s_sleep(1); \
    if ((++_sp & 255u) == 0u) { if (xb_ld(&(bar)[XB_TMO])) break; if (_sp > XB_SPIN_CAP) { atomicAdd(&(bar)[XB_TMO], 1u); break; } } } } while (0)
struct XcdBarrier { unsigned* bar; unsigned x; volatile LAS unsigned* st; };
DI XcdBarrier xcd_barrier_post(unsigned* bar, volatile LAS unsigned* st) {
    XcdBarrier b; b.bar = bar; b.x = xb_xcc_id(); b.st = st;
    if (threadIdx.x == 0) (void)xb_add(&bar[XB_XCNT(b.x)], 1u);
    return b;
}
DI void xcd_barrier_complete(unsigned* bar, unsigned x, unsigned& nloc, unsigned& nx) {
    const unsigned G = gridDim.x * gridDim.y * gridDim.z;
    unsigned sum, cnt, mine, sp = 0u;
    for (;;) {
        sum = 0u; cnt = 0u; mine = 0u;
#pragma unroll
        for (unsigned j = 0; j < 16; ++j) { const unsigned c = xb_ld(&bar[XB_XCNT(j)]); sum += c; cnt += (c > 0u) ? 1u : 0u; mine = (j == x) ? c : mine; }
        if (sum == G) break;
        __builtin_amdgcn_s_sleep(1);
        if ((++sp & 255u) == 0u) { if (xb_ld(&bar[XB_TMO])) break; if (sp > XB_SPIN_CAP) { atomicAdd(&bar[XB_TMO], 1u); break; } }
    }
    nloc = mine > 0u ? mine : 1u; nx = cnt > 0u ? cnt : 1u;
}
DI void xcd_barrier(const XcdBarrier& b) {
    asm volatile("s_waitcnt vmcnt(0)" ::: "memory");
    __syncthreads();
    if (threadIdx.x == 0) {
        unsigned* bar = b.bar;
        __builtin_amdgcn_s_waitcnt(0);
        unsigned nloc = b.st[0], nx = b.st[1];
        if (nloc == 0u) { xcd_barrier_complete(bar, b.x, nloc, nx); b.st[0] = nloc; b.st[1] = nx; }
        const unsigned old = xb_add(&bar[XB_XSUB(b.x)], 1u);
        const unsigned gen = old / nloc;
        if (old + 1u == (gen + 1u) * nloc) {
            __builtin_amdgcn_fence(__ATOMIC_RELEASE, "agent");
            asm volatile("s_waitcnt vmcnt(0)" ::: "memory");
            const unsigned og = xb_add(&bar[XB_TOP], 1u);
            const unsigned tg = og / nx;
            if (og + 1u == (tg + 1u) * nx) xb_add(&bar[XB_TOPGEN], 1u);
            else XB_SPIN(xb_ld(&bar[XB_TOPGEN]) == tg, bar);
            __builtin_amdgcn_fence(__ATOMIC_ACQUIRE, "agent");
            xb_add(&bar[XB_XGEN(b.x)], 1u);
            asm volatile("s_waitcnt vmcnt(0)" ::: "memory");
        } else {
            XB_SPIN(xb_ld(&bar[XB_XGEN(b.x)]) == gen, bar);
            __builtin_amdgcn_fence(__ATOMIC_ACQUIRE, "agent");
            asm volatile("s_waitcnt vmcnt(0)" ::: "memory");
        }
    }
    __syncthreads();
}
#define GSYNC_CG() do { asm volatile("s_waitcnt vmcnt(0)" ::: "memory"); grid.sync(); } while (0)
#define GSYNC() do { XcdBarrier xb_; xb_.bar = (unsigned*)(p.ws + OFF_BAR); xb_.x = xb_xcc_id(); xb_.st = (volatile LAS unsigned*)((LAS char*)lds + XB_LDS_OFF); xcd_barrier(xb_); } while (0)
__global__ void __launch_bounds__(512) mega(Params p) {
    extern __shared__ __attribute__((aligned(16))) char lds[];
    cg::grid_group grid = cg::this_grid();
    const int tid = threadIdx.x, wid = tid >> 6, lane = tid & 63;
    char* ws = p.ws;
    if (tid < 4) ((volatile LAS unsigned*)((LAS char*)lds + XB_LDS_OFF))[tid] = 0u;
    __syncthreads();
    (void)xcd_barrier_post((unsigned*)(ws + OFF_BAR), (volatile LAS unsigned*)((LAS char*)lds + XB_LDS_OFF));
    bf16_t* w_gin = (bf16_t*)(ws + OFF_GIN); bf16_t* w_gout = (bf16_t*)(ws + OFF_GOUT); bf16_t* w_gs = (bf16_t*)(ws + OFF_GS);
    bf16_t* w_qkv = (bf16_t*)(ws + OFF_QKV); bf16_t* w_dout = (bf16_t*)(ws + OFF_DOUT); bf16_t* w_fin = (bf16_t*)(ws + OFF_FIN); bf16_t* w_fout = (bf16_t*)(ws + OFF_FOUT);
    f32x2* rope = (f32x2*)(ws + OFF_ROPE);
    bf16_t* hb = (bf16_t*)(ws + OFF_H); bf16_t* big = (bf16_t*)(ws + OFF_BIG); bf16_t* halo = (bf16_t*)(ws + OFF_HALO);
    bf16_t* yo = (bf16_t*)p.out;

    bf16_t* hb2 = (bf16_t*)(ws + OFF_H2); float* ssq = (float*)(ws + OFF_SSQ);
    for (int j = 0; j < 2; ++j) {
        convert_T(p.in[5] + (long)j * 1024 * 2048, 1024, 2048, w_gin + (long)j * 2048 * 1024, false, p.in[2] + (2 * j) * 1024, lds, tid);
        convert_T(p.in[9] + (long)j * 1024 * 1024, 1024, 1024, w_gout + (long)j * 1024 * 1024, false, nullptr, lds, tid);
        convert_T(p.in[10] + (long)j * 1024 * 3072, 1024, 3072, w_qkv + (long)j * 3072 * 1024, false, p.in[2] + (2 * j + 1) * 1024, lds, tid);
        convert_T(p.in[16] + (long)j * 1024 * 1024, 1024, 1024, w_dout + (long)j * 1024 * 1024, false, nullptr, lds, tid);
    }
    for (int j = 0; j < 4; ++j) {
        convert_T(p.in[17] + (long)j * 1024 * 5632, 1024, 5632, w_fin + (long)j * 5632 * 1024, true, p.in[3] + j * 1024, lds, tid);
        convert_T(p.in[20] + (long)j * 2816 * 1024, 2816, 1024, w_fout + (long)j * 1024 * 2816, false, nullptr, lds, tid);
    }
    for (int idx = blockIdx.x * NTH + tid; idx < 2 * 8 * 128 * 128; idx += gridDim.x * NTH) w_gs[idx] = bf1(p.in[7][idx]);
    for (int idx = blockIdx.x * NTH + tid; idx < 8192 * 32; idx += gridDim.x * NTH) {
        const int pos = idx >> 5, i = idx & 31;
        const float ang = (float)pos * p.inv_freq[i];
        const double a = (double)ang;
        const double n = rint(a * 0.15915494309189535);
        double r = fma(-n, 6.283185307179586, a);
        r = fma(-n, 2.4492935982947064e-16, r);
        const float rf = (float)r;
        f32x2 cs; cs.x = cosf(rf); cs.y = sinf(rf);
        rope[idx] = cs;
    }
    for (int row = blockIdx.x * 8 + wid; row < T; row += gridDim.x * 8) {
        const float* xr = row < TP ? p.in[0] + (long)row * 1024 : p.in[1] + (long)(row - TP) * 1024;
        float ss = 0.f;
#pragma unroll
        for (int jj = 0; jj < 4; ++jj) {
            const f32x4 v = ((const f32x4*)xr)[lane + 64 * jj];
            u32x2 w; w.x = pk2(v.x, v.y); w.y = pk2(v.z, v.w);
            ((u32x2*)(hb + (long)row * 1024))[lane + 64 * jj] = w;
            const float a0 = bflo(w.x), a1 = bfhi(w.x), a2 = bflo(w.y), a3 = bfhi(w.y);
            ss += (a0 * a0 + a1 * a1) + (a2 * a2 + a3 * a3);
        }
        ss = wave_sum(ss);
        if (lane == 0) { f32x4 q = {ss, 0.f, 0.f, 0.f}; *(f32x4*)(ssq + (long)row * 4) = q; }
    }
    GSYNC_CG();

    for (int layer = 0; layer < 4; ++layer) {
        const int j = layer >> 1;
        char* wsl = p.ws; asm volatile("" : "+s"(wsl));
        bf16_t* w_gin = (bf16_t*)(wsl + OFF_GIN); bf16_t* w_gout = (bf16_t*)(wsl + OFF_GOUT); bf16_t* w_gs = (bf16_t*)(wsl + OFF_GS);
        bf16_t* w_qkv = (bf16_t*)(wsl + OFF_QKV); bf16_t* w_dout = (bf16_t*)(wsl + OFF_DOUT); bf16_t* w_fin = (bf16_t*)(wsl + OFF_FIN); bf16_t* w_fout = (bf16_t*)(wsl + OFF_FOUT);
        f32x2* rope = (f32x2*)(wsl + OFF_ROPE);
        bf16_t* hb = (bf16_t*)(wsl + OFF_H); bf16_t* big = (bf16_t*)(wsl + OFF_BIG); bf16_t* halo = (bf16_t*)(wsl + OFF_HALO);
        bf16_t* hb2 = (bf16_t*)(wsl + OFF_H2); float* ssq = (float*)(wsl + OFF_SSQ);
        bf16_t* yo = (bf16_t*)p.out; asm volatile("" : "+s"(yo));
        if ((layer & 1) == 0) {
            { EpiGelu e{big}; gemm_phase(hb, 1024, w_gin + (long)j * 2048 * 1024, 1024, 2048, 1024, e, ssq, lds, tid); }
            GSYNC();
            spatial_phase(big, w_gs + (long)j * 8 * 128 * 128, p.in[6] + j * 1024, p.in[8] + j * 1024, yo, lds, tid, wid, lane);
            GSYNC();
            { EpiResid e{hb, hb2, ssq}; gemm_phase(yo, 1024, w_gout + (long)j * 1024 * 1024, 1024, 1024, 1024, e, ssq, lds, tid); }
            GSYNC();
        } else {
            bf16_t* qb = big; bf16_t* kb = big + (long)T * 1024; bf16_t* vt = big + (long)T * 2048;
            { EpiQkv e{qb, kb, vt, rope}; gemm_phase(hb, 1024, w_qkv + (long)j * 3072 * 1024, 1024, 3072, 1024, e, ssq, lds, tid); }
            GSYNC();
            const float lam_init = 0.8f - 0.6f * expf(-0.3f * (float)layer);
            attn_phase(qb, kb, vt, yo, p.in[11] + j * 64, p.in[12] + j * 64, p.in[13] + j * 64, p.in[14] + j * 64, p.in[15] + j * 128, lam_init, lds, tid, wid, lane);
            GSYNC();
            { EpiResid e{hb, hb2, ssq}; gemm_phase(yo, 1024, w_dout + (long)j * 1024 * 1024, 1024, 1024, 1024, e, ssq, lds, tid); }
            GSYNC();
        }
        { EpiFfn e{p.in[18] + (long)layer * 3 * 5632, p.in[19] + (long)layer * 5632, big, halo};
          gemm_phase(hb2, 1024, w_fin + (long)layer * 5632 * 1024, 1024, 5632, 1024, e, ssq, lds, tid); }
        GSYNC();
        ffn_fixup(halo, p.in[18] + (long)layer * 3 * 5632, p.in[19] + (long)layer * 5632, big, tid);
        GSYNC();
        { EpiResid e{hb2, hb, ssq}; gemm_phase(big, 2816, w_fout + (long)layer * 1024 * 2816, 2816, 1024, 2816, e, ssq, lds, tid); }
        GSYNC();
    }
    {
        int t_end = threadIdx.x; asm volatile("" : "+v"(t_end));
        char* wse = p.ws; asm volatile("" : "+s"(wse));
        final_norm((const bf16_t*)(wse + OFF_H), p.in[4], p.out, t_end >> 6, t_end & 63);
    }
}

extern "C" void kernel_launch(void* const* d_in, const int* in_sizes, int n_in, void* d_out, int out_size, void* d_ws, size_t ws_size,
                              hipStream_t stream) {
    static int grid_blocks = 0;
    if (grid_blocks == 0) {
        if (n_in != 21 || out_size != T * D || ws_size < WS_END) { fprintf(stderr, "kernel_launch: unexpected sizes n_in %d out %d ws %zu (need %zu)\n", n_in, out_size, ws_size, (size_t)WS_END); grid_blocks = -1; return; }
        int dev = 0, cus = 0, per_cu = 0;
        hipGetDevice(&dev);
        hipDeviceGetAttribute(&cus, hipDeviceAttributeMultiprocessorCount, dev);
        hipFuncSetAttribute((const void*)mega, hipFuncAttributeMaxDynamicSharedMemorySize, LDS_BYTES);
        hipOccupancyMaxActiveBlocksPerMultiprocessor(&per_cu, (const void*)mega, NTH, LDS_BYTES);
        if (per_cu < 1) { fprintf(stderr, "kernel_launch: occupancy query says %d blocks/CU\n", per_cu); per_cu = 1; }
        grid_blocks = cus * per_cu;
        (void)hipGetLastError();
    }
    if (grid_blocks < 0) return;
    Params p{};
    for (int i = 0; i < 21; ++i) p.in[i] = (const float*)d_in[i];
    p.out = (float*)d_out; p.ws = (char*)d_ws;
    for (int i = 0; i < 32; ++i) p.inv_freq[i] = (float)pow(10000.0, -(double)i / 32.0);
    (void)hipMemsetAsync((char*)d_ws + OFF_BAR, 0, 3456 * 4, stream);
    void* args[] = {&p};
    hipError_t e = hipLaunchCooperativeKernel((const void*)mega, dim3(grid_blocks), dim3(NTH), args, LDS_BYTES, stream);
    if (e != hipSuccess) fprintf(stderr, "cooperative launch failed: %s (grid %d)\n", hipGetErrorString(e), grid_blocks);
}
```

```cpp
#include <hip/hip_runtime.h>
#include <hip/hip_cooperative_groups.h>
#include <cmath>
#include <cstdio>
namespace cg = cooperative_groups;

typedef unsigned short bf16_t;
typedef short bf16x8 __attribute__((ext_vector_type(8)));
typedef float f32x16 __attribute__((ext_vector_type(16)));
typedef float f32x4 __attribute__((ext_vector_type(4)));
typedef float f32x2 __attribute__((ext_vector_type(2)));
typedef unsigned u32x4 __attribute__((ext_vector_type(4)));
typedef unsigned u32x2 __attribute__((ext_vector_type(2)));
typedef __bf16 bf16x2_t __attribute__((ext_vector_type(2)));

#define DI __device__ __forceinline__
#define MFMA(a, b, c) __builtin_amdgcn_mfma_f32_32x32x16_bf16((a), (b), (c), 0, 0, 0)
#define MFMA16(a, b, c) __builtin_amdgcn_mfma_f32_16x16x32_bf16((a), (b), (c), 0, 0, 0)
typedef f32x4 gacc_t[8][4];

constexpr int T = 81920, TP = 16384, D = 1024, NTH = 512;
constexpr int XB_LDS_OFF = 256 * 528 + 1024;
constexpr int LDS_BYTES = 256 * 528 + 1024 + 16;

constexpr size_t OFF_GIN = 0;
constexpr size_t OFF_GOUT = OFF_GIN + 2ull * 2048 * 1024 * 2;
constexpr size_t OFF_GS = OFF_GOUT + 2ull * 1024 * 1024 * 2;
constexpr size_t OFF_QKV = OFF_GS + 2ull * 8 * 128 * 128 * 2;
constexpr size_t OFF_DOUT = OFF_QKV + 2ull * 3072 * 1024 * 2;
constexpr size_t OFF_FIN = OFF_DOUT + 2ull * 1024 * 1024 * 2;
constexpr size_t OFF_FOUT = OFF_FIN + 4ull * 5632 * 1024 * 2;
constexpr size_t OFF_ROPE = OFF_FOUT + 4ull * 1024 * 2816 * 2;
constexpr size_t OFF_H = OFF_ROPE + 8192ull * 32 * 8;
constexpr size_t OFF_BIG = OFF_H + (size_t)T * 1024 * 2;
constexpr size_t OFF_HALO = OFF_BIG + (size_t)T * 3072 * 2;
constexpr size_t OFF_H2 = OFF_HALO + 320ull * 4 * 5632 * 2;
constexpr size_t OFF_SSQ = OFF_H2 + (size_t)T * 1024 * 2;
constexpr size_t OFF_BAR = OFF_SSQ + (size_t)T * 4 * 4;
constexpr size_t WS_END = OFF_BAR + 3456 * 4;
constexpr int RSTD_OFF = 256 * 528;

struct Params {
    const float* in[21];
    float* out;
    char* ws;
    float inv_freq[32];
};

DI unsigned pk2(float a, float b) { f32x2 v = {a, b}; bf16x2_t r = __builtin_convertvector(v, bf16x2_t); return __builtin_bit_cast(unsigned, r); }
DI bf16_t bf1(float a) { return (bf16_t)(pk2(a, 0.f) & 0xffffu); }
DI float bflo(unsigned w) { return __uint_as_float(w << 16); }
DI float bfhi(unsigned w) { return __uint_as_float(w & 0xffff0000u); }
DI float wave_sum(float v) {
#pragma unroll
    for (int o = 1; o < 64; o <<= 1) v += __shfl_xor(v, o);
    return v;
}
DI int crow(int i, int h) { return (i & 3) + 8 * (i >> 2) + 4 * h; }
DI int swz(int row, int chunk) { return row * 128 + ((chunk ^ ((row >> 1) & 7)) << 4); }
DI bf16x8 ldfrag(const char* lds, int row, int chunk) { return *(const bf16x8*)(lds + swz(row, chunk)); }
DI bool is_seq_start(int R) { return R < TP ? (R & 4095) == 0 : ((R - TP) & 8191) == 0; }

#define GAS __attribute__((address_space(1)))
#define LAS __attribute__((address_space(3)))
template <bool RSTD, bool SWAP>
DI void gemm_tile(gacc_t& acc, const bf16_t* __restrict__ A, int lda, const bf16_t* __restrict__ Bt, int ldb, int K,
                  char* lds, int tid, int wr, int wc, int lane, const float* ssq_row) {
#pragma unroll
    for (int m = 0; m < 8; ++m)
#pragma unroll
        for (int n = 0; n < 4; ++n)
#pragma unroll
            for (int j = 0; j < 4; ++j) acc[m][n][j] = 0.f;
    const int nk = K / 64;
    const int fr = lane & 15, fq = lane >> 4;
    const int srow = tid >> 3, sch = tid & 7;
    const int cl = sch ^ ((srow >> 1) & 7);
    const int wv = __builtin_amdgcn_readfirstlane(tid >> 6);
    const bf16_t* ap = A + (long)srow * lda + cl * 8;
    const bf16_t* bp = Bt + (long)srow * ldb + cl * 8;
    LAS char* l3 = (LAS char*)lds;
#define GEMM_ISSUE(KT, ST) do { \
        _Pragma("unroll") for (int i_ = 0; i_ < 4; ++i_) { \
            __builtin_amdgcn_global_load_lds((const GAS unsigned*)(ap + (long)(64 * i_) * lda + (KT) * 64), (LAS unsigned*)(l3 + (ST) * 65536 + i_ * 8192 + wv * 1024), 16, 0, 0); \
            __builtin_amdgcn_global_load_lds((const GAS unsigned*)(bp + (long)(64 * i_) * ldb + (KT) * 64), (LAS unsigned*)(l3 + (ST) * 65536 + 32768 + i_ * 8192 + wv * 1024), 16, 0, 0); \
        } } while (0)
    GEMM_ISSUE(0, 0);
    if (RSTD && tid < 256) {
        const f32x4 q = *(const f32x4*)ssq_row;
        ((float*)(lds + RSTD_OFF))[tid] = 1.0f / sqrtf(((q.x + q.y) + (q.z + q.w)) * (1.0f / 1024.0f) + 1e-6f);
    }
    asm volatile("s_waitcnt vmcnt(0)" ::: "memory");
    __syncthreads();
    for (int kt = 0; kt < nk; ++kt) {
        const char* cur = lds + (kt & 1) * 65536;
        if (kt + 1 < nk) GEMM_ISSUE(kt + 1, (kt + 1) & 1);
        bf16x8 bfr[2][4], afr[3];
#pragma unroll
        for (int n = 0; n < 4; ++n) bfr[0][n] = ldfrag(cur + 32768, wc * 64 + n * 16 + fr, fq);
        afr[0] = ldfrag(cur, wr * 128 + fr, fq);
        afr[1] = ldfrag(cur, wr * 128 + 16 + fr, fq);
#pragma unroll
        for (int idx = 0; idx < 16; ++idx) {
            const int ks = idx >> 3, m = idx & 7;
            if (idx < 14) afr[(idx + 2) % 3] = ldfrag(cur, wr * 128 + ((idx + 2) & 7) * 16 + fr, ((idx + 2) >> 3) * 4 + fq);
            if (ks == 0 && m >= 2 && m < 6) bfr[1][m - 2] = ldfrag(cur + 32768, wc * 64 + (m - 2) * 16 + fr, 4 + fq);
#pragma unroll
            for (int n = 0; n < 4; ++n) acc[m][n] = SWAP ? MFMA16(bfr[ks][n], afr[idx % 3], acc[m][n]) : MFMA16(afr[idx % 3], bfr[ks][n], acc[m][n]);
        }
        __builtin_amdgcn_sched_group_barrier(0x100, 6, 0);
#define GEMM_SG1() do { __builtin_amdgcn_sched_group_barrier(0x100, 1, 0); __builtin_amdgcn_sched_group_barrier(0x008, 4, 0); } while (0)
#define GEMM_SG2() do { __builtin_amdgcn_sched_group_barrier(0x100, 2, 0); __builtin_amdgcn_sched_group_barrier(0x008, 4, 0); } while (0)
        GEMM_SG1(); GEMM_SG1(); GEMM_SG2(); GEMM_SG2(); GEMM_SG2(); GEMM_SG2(); GEMM_SG1(); GEMM_SG1();
        GEMM_SG1(); GEMM_SG1(); GEMM_SG1(); GEMM_SG1(); GEMM_SG1(); GEMM_SG1();
        __builtin_amdgcn_sched_group_barrier(0x008, 8, 0);
        __builtin_amdgcn_sched_barrier(0);
        asm volatile("s_waitcnt vmcnt(0)" ::: "memory");
        __syncthreads();
    }
}

DI bool tile_order(int L, int nM, int nN, int& pm, int& pn) {
    const int nwg = nM * nN;
    if (L >= nwg) return false;
    int wgid = L;
    { const int q = nwg / 8, r = nwg % 8, xcd = wgid % 8, off = wgid / 8; wgid = (xcd < r ? xcd * (q + 1) : r * (q + 1) + (xcd - r) * q) + off; }
    const int nig = 8 * nN, gid = wgid / nig, fm = gid * 8, gsz = (nM - fm) < 8 ? (nM - fm) : 8;
    pm = fm + ((wgid % nig) % gsz); pn = (wgid % nig) / gsz;
    return true;
}

DI void store_tile_from_lds(const char* lds, bf16_t* dst, long ld, int tid) {
#pragma unroll
    for (int k = 0; k < 16; ++k) {
        const int id = tid + NTH * k, row = id >> 5, ch = id & 31;
        const u32x4 v = *(const u32x4*)(lds + row * 528 + ch * 16);
        *(u32x4*)(dst + (long)row * ld + ch * 8) = v;
    }
}
struct EpiGelu {
    static constexpr bool NEEDS_RSTD = true;
    static DI bool swap_tile(int) { return true; }
    bf16_t* z;
    DI void operator()(gacc_t& acc, int pm, int pn, char* lds, int tid, int wr, int wc, int lane) const {
        asm volatile("" : "+v"(tid), "+v"(lane));
        const int fr = lane & 15, fq = lane >> 4;
        char* lbase = lds + (wr * 128 + fr) * 528 + (wc * 64 + 4 * fq) * 2;
        const float* rl = (const float*)(lds + RSTD_OFF) + wr * 128 + fr;
#pragma unroll
        for (int m = 0; m < 8; ++m) {
            const float r = rl[m * 16];
#pragma unroll
            for (int n = 0; n < 4; ++n) {
                float g[4];
#pragma unroll
                for (int j = 0; j < 4; ++j) {
                    const float x = acc[m][n][j] * r;
                    const float u = 0.7978845608028654f * (x + 0.044715f * x * x * x);
                    const float e = __builtin_amdgcn_exp2f(-2.885390081777927f * u);
                    g[j] = x * __builtin_amdgcn_rcpf(1.0f + e);
                }
                u32x2 w; w.x = pk2(g[0], g[1]); w.y = pk2(g[2], g[3]);
                *(u32x2*)(lbase + m * 16 * 528 + n * 32) = w;
            }
            __builtin_amdgcn_sched_barrier(0);
        }
        __syncthreads();
        store_tile_from_lds(lds, z + (long)pm * 256 * 2048 + pn * 256, 2048, tid);
        __syncthreads();
    }
};
struct EpiResid {
    static constexpr bool NEEDS_RSTD = false;
    static DI bool swap_tile(int) { return true; }
    const bf16_t* xold; bf16_t* xnew; float* ssq;
    DI void operator()(gacc_t& acc, int pm, int pn, char* lds, int tid, int wr, int wc, int lane) const {
        asm volatile("" : "+v"(tid), "+v"(lane));
        const int fr = lane & 15, fq = lane >> 4, wid = tid >> 6;
        char* lbase = lds + (wr * 128 + fr) * 528 + (wc * 64 + 4 * fq) * 2;
#pragma unroll
        for (int m = 0; m < 8; ++m)
#pragma unroll
            for (int n = 0; n < 4; ++n) { u32x2 w; w.x = pk2(acc[m][n][0], acc[m][n][1]); w.y = pk2(acc[m][n][2], acc[m][n][3]); *(u32x2*)(lbase + m * 16 * 528 + n * 32) = w; }
        __builtin_amdgcn_sched_barrier(0);
        __syncthreads();
        __builtin_amdgcn_sched_barrier(0);
        const int g = lane >> 5, j32 = lane & 31;
#pragma unroll
        for (int ib = 0; ib < 4; ++ib) {
            __builtin_amdgcn_sched_barrier(0);
            u32x4 xv[4];
#pragma unroll
            for (int u = 0; u < 4; ++u) {
                const long row = (long)pm * 256 + (ib * 4 + u) * 16 + wid * 2 + g;
                xv[u] = *(const u32x4*)(xold + row * 1024 + pn * 256 + j32 * 8);
            }
#pragma unroll
            for (int u = 0; u < 4; ++u) {
                const int rloc = (ib * 4 + u) * 16 + wid * 2 + g;
                const long row = (long)pm * 256 + rloc;
                const u32x4 a = *(const u32x4*)(lds + rloc * 528 + j32 * 16);
                u32x4 w; float ss = 0.f;
#pragma unroll
                for (int e = 0; e < 4; ++e) {
                    w[e] = pk2(bflo(xv[u][e]) + bflo(a[e]), bfhi(xv[u][e]) + bfhi(a[e]));
                    const float b0 = bflo(w[e]), b1 = bfhi(w[e]);
                    ss += b0 * b0 + b1 * b1;
                }
                *(u32x4*)(xnew + row * 1024 + pn * 256 + j32 * 8) = w;
#pragma unroll
                for (int o = 1; o < 32; o <<= 1) ss += __shfl_xor(ss, o);
                if (j32 == 0) ssq[row * 4 + pn] = ss;
            }
        }
        __syncthreads();
    }
};
struct EpiQkv {
    static constexpr bool NEEDS_RSTD = true;
    static DI bool swap_tile(int) { return false; }
    bf16_t* qb; bf16_t* kb; bf16_t* vt; const f32x2* rope;
    DI void operator()(gacc_t& acc, int pm, int pn, char* lds, int tid, int wr, int wc, int lane) const {
        asm volatile("" : "+v"(tid), "+v"(lane));
        const int fr = lane & 15, fq = lane >> 4;
        const int col0 = pn * 256 + wc * 64;
        const int region = col0 >> 10, cr = col0 & 1023;
        const int R0 = pm * 256;
        const int t0 = R0 < TP ? (R0 & ~4095) : TP + ((R0 - TP) & ~8191);
        const int S = R0 < TP ? 4096 : 8192;
        const float* rl = (const float*)(lds + RSTD_OFF) + wr * 128 + 4 * fq;
        if (region < 2) {
            const float sc = region == 0 ? 0.18033688011112042f : 1.0f;
            char* lbase = lds + (wr * 128 + 4 * fq) * 528 + (wc * 64 + fr) * 2;
            const f32x2* rbase = rope + (R0 - t0 + wr * 128 + 4 * fq) * 32 + fr;
#pragma unroll
            for (int m = 0; m < 8; ++m) {
#pragma unroll
                for (int j = 0; j < 4; ++j) {
                    const int ro = m * 16 + j;
                    const float rs = rl[ro] * sc;
#pragma unroll
                    for (int n = 0; n < 2; ++n) {
                        const f32x2 cs = rbase[ro * 32 + n * 16];
                        const float x1 = acc[m][n][j], x2 = acc[m][n + 2][j];
                        const float o1 = (x1 * cs.x - x2 * cs.y) * rs, o2 = (x2 * cs.x + x1 * cs.y) * rs;
                        *(bf16_t*)(lbase + ro * 528 + n * 32) = bf1(o1); *(bf16_t*)(lbase + ro * 528 + n * 32 + 64) = bf1(o2);
                    }
                }
                __builtin_amdgcn_sched_barrier(0);
            }
        } else {
            const int head = cr >> 7;
            const int kbase = (R0 - t0) + wr * 128 + 8 * (fq & 1) + 4 * (fq >> 1);
#pragma unroll
            for (int n = 0; n < 4; ++n) {
                const int e = (cr & 127) + n * 16 + fr;
                bf16_t* vrow = vt + (long)t0 * 1024 + (long)(head * 128 + e) * S + kbase;
#pragma unroll
                for (int m = 0; m < 8; ++m) {
                    const float* rq = rl + m * 16;
                    u32x2 w;
                    w.x = pk2(acc[m][n][0] * rq[0], acc[m][n][1] * rq[1]); w.y = pk2(acc[m][n][2] * rq[2], acc[m][n][3] * rq[3]);
                    *(u32x2*)(vrow + (m >> 1) * 32 + 16 * (m & 1)) = w;
                }
                __builtin_amdgcn_sched_barrier(0);
            }
        }
        if (pn < 8) {
            __syncthreads();
            store_tile_from_lds(lds, (pn < 4 ? qb : kb) + (long)R0 * 1024 + (pn & 3) * 256, 1024, tid);
            __syncthreads();
        }
    }
};
struct EpiFfn {
    static constexpr bool NEEDS_RSTD = true;
    static DI bool swap_tile(int) { return true; }
    const float* cw; const float* cb; bf16_t* act; bf16_t* halo;
    DI void operator()(gacc_t& acc, int pm, int pn, char* lds, int tid, int wr, int wc, int lane) const {
        asm volatile("" : "+v"(tid), "+v"(lane));
        const int fr = lane & 15, fq = lane >> 4;
        constexpr int RS = 528;
        const float* rl = (const float*)(lds + RSTD_OFF) + wr * 128 + fr;
        {
            char* lbase = lds + (wr * 128 + fr) * RS + (wc * 64 + 4 * fq) * 2;
            bf16_t* hrow = halo + (long)(pm * 4) * 5632 + pn * 256 + wc * 64 + 4 * fq;
#pragma unroll
            for (int m = 0; m < 8; ++m) {
                const float r = rl[m * 16];
#pragma unroll
                for (int n = 0; n < 4; ++n) {
                    u32x2 w; w.x = pk2(acc[m][n][0] * r, acc[m][n][1] * r); w.y = pk2(acc[m][n][2] * r, acc[m][n][3] * r);
                    *(u32x2*)(lbase + m * 16 * RS + n * 32) = w;
                    if (m == 0 && wr == 0 && fr < 2) *(u32x2*)(hrow + fr * 5632 + n * 16) = w;
                    if (m == 7 && wr == 1 && fr >= 14) *(u32x2*)(hrow + (fr - 12) * 5632 + n * 16) = w;
                }
            }
        }
        __syncthreads();
        const int cgp = tid & 15, rs = tid >> 4;
        const int jg = pn * 128 + cgp * 8;
        float wg[3][8], wu[3][8], bg[8], bu[8];
#pragma unroll
        for (int t = 0; t < 3; ++t) {
            const f32x4 a0 = *(const f32x4*)(cw + t * 5632 + jg), a1 = *(const f32x4*)(cw + t * 5632 + jg + 4);
            const f32x4 b0 = *(const f32x4*)(cw + t * 5632 + 2816 + jg), b1 = *(const f32x4*)(cw + t * 5632 + 2816 + jg + 4);
#pragma unroll
            for (int e = 0; e < 4; ++e) { wg[t][e] = a0[e]; wg[t][4 + e] = a1[e]; wu[t][e] = b0[e]; wu[t][4 + e] = b1[e]; }
        }
        {
            const f32x4 a0 = *(const f32x4*)(cb + jg), a1 = *(const f32x4*)(cb + jg + 4);
            const f32x4 b0 = *(const f32x4*)(cb + 2816 + jg), b1 = *(const f32x4*)(cb + 2816 + jg + 4);
#pragma unroll
            for (int e = 0; e < 4; ++e) { bg[e] = a0[e]; bg[4 + e] = a1[e]; bu[e] = b0[e]; bu[4 + e] = b1[e]; }
        }
        const char* gbase = lds + ((cgp >> 2) * 64 + (cgp & 3) * 8) * 2;
        const int R0 = pm * 256;
        const bool first = is_seq_start(R0), last = is_seq_start(R0 + 256);
        float pg[8], pu[8], cg_[8], cu[8];
        const int r0 = rs * 8;
        auto ldrow = [&](int row, float (&g)[8], float (&u)[8]) {
            if (row < 0 || row > 255) {
#pragma unroll
                for (int e = 0; e < 8; ++e) { g[e] = 0.f; u[e] = 0.f; }
            } else {
                const u32x4 a = *(const u32x4*)(gbase + row * RS), b = *(const u32x4*)(gbase + row * RS + 64);
                g[0] = bflo(a.x); g[1] = bfhi(a.x); g[2] = bflo(a.y); g[3] = bfhi(a.y); g[4] = bflo(a.z); g[5] = bfhi(a.z); g[6] = bflo(a.w); g[7] = bfhi(a.w);
                u[0] = bflo(b.x); u[1] = bfhi(b.x); u[2] = bflo(b.y); u[3] = bfhi(b.y); u[4] = bflo(b.z); u[5] = bfhi(b.z); u[6] = bflo(b.w); u[7] = bfhi(b.w);
            }
        };
        ldrow(r0 - 1, pg, pu);
        ldrow(r0, cg_, cu);
#pragma unroll
        for (int rr = 0; rr < 8; ++rr) {
            const int row = r0 + rr;
            float ng[8], nu[8];
            ldrow(row + 1, ng, nu);
            float o[8];
#pragma unroll
            for (int e = 0; e < 8; ++e) {
                const float g = bg[e] + wg[0][e] * pg[e] + wg[1][e] * cg_[e] + wg[2][e] * ng[e];
                const float u = bu[e] + wu[0][e] * pu[e] + wu[1][e] * cu[e] + wu[2][e] * nu[e];
                const float sg = g * __builtin_amdgcn_rcpf(1.0f + __builtin_amdgcn_exp2f(-1.4426950408889634f * g));
                o[e] = sg * u;
            }
            const bool skip = (row == 0 && !first) || (row == 255 && !last);
            if (!skip) {
                u32x4 w; w.x = pk2(o[0], o[1]); w.y = pk2(o[2], o[3]); w.z = pk2(o[4], o[5]); w.w = pk2(o[6], o[7]);
                *(u32x4*)(act + (long)(R0 + row) * 2816 + jg) = w;
            }
#pragma unroll
            for (int e = 0; e < 8; ++e) { pg[e] = cg_[e]; pu[e] = cu[e]; cg_[e] = ng[e]; cu[e] = nu[e]; }
        }
        __syncthreads();
    }
};

template <class Epi>
DI void gemm_phase(const bf16_t* A, int lda, const bf16_t* Bt, int ldb, int N, int K, const Epi& epi, const float* ssq, char* lds, int tid) {
    asm volatile("" : "+v"(tid));
    const int wid = tid >> 6, lane = tid & 63, wr = wid >> 2, wc = wid & 3;
    const int nM = T / 256, nN = N / 256;
    for (int it = 0;; ++it) {
        int pm, pn;
        if (!tile_order(it * (int)gridDim.x + (int)blockIdx.x, nM, nN, pm, pn)) break;
        if (Epi::NEEDS_RSTD) __syncthreads();
        gacc_t acc;
        if (Epi::swap_tile(pn)) gemm_tile<Epi::NEEDS_RSTD, true>(acc, A + (long)pm * 256 * lda, lda, Bt + (long)pn * 256 * ldb, ldb, K, lds, tid, wr, wc, lane, ssq + (long)(pm * 256 + (tid & 255)) * 4);
        else gemm_tile<Epi::NEEDS_RSTD, false>(acc, A + (long)pm * 256 * lda, lda, Bt + (long)pn * 256 * ldb, ldb, K, lds, tid, wr, wc, lane, ssq + (long)(pm * 256 + (tid & 255)) * 4);
        epi(acc, pm, pn, lds, tid, wr, wc, lane);
    }
}

DI void convert_T(const float* __restrict__ W, int K, int N, bf16_t* __restrict__ Wt, bool permute, const float* __restrict__ gain, char* lds, int tid) {
    asm volatile("" : "+v"(tid));
    float* tile = (float*)lds;
    const int nnb = N / 64, ntiles = (K / 64) * nnb;
    for (int it = blockIdx.x; it < ntiles; it += gridDim.x) {
        const int k0 = (it / nnb) * 64, n0 = (it % nnb) * 64;
#pragma unroll
        for (int i = 0; i < 8; ++i) { const int idx = tid + NTH * i, kr = idx >> 6, nc = idx & 63; tile[kr * 65 + nc] = W[(long)(k0 + kr) * N + n0 + nc]; }
        __syncthreads();
#pragma unroll
        for (int i = 0; i < 8; ++i) {
            const int idx = tid + NTH * i, nr = idx >> 6, kc = idx & 63; const int n = n0 + nr; int nd = n;
            if (permute) { if (n < 2816) nd = (n >> 5) * 64 + (n & 31); else { const int j = n - 2816; nd = (j >> 5) * 64 + 32 + (j & 31); } }
            Wt[(long)nd * K + k0 + kc] = bf1(tile[kc * 65 + nr] * (gain ? gain[k0 + kc] : 1.0f));
        }
        __syncthreads();
    }
}

template <bool FINAL>
DI void norm_rows(const float* src0, const float* src1, const float* __restrict__ g, bf16_t* dst, float* fdst, float* copy, int wid, int lane) {
    asm volatile("" : "+v"(wid), "+v"(lane));
    for (int row = blockIdx.x * 8 + wid; row < T; row += gridDim.x * 8) {
        const float* xr = row < TP ? src0 + (long)row * 1024 : src1 + (long)(row - TP) * 1024;
        f32x4 v[4]; float ss = 0.f;
#pragma unroll
        for (int j = 0; j < 4; ++j) { v[j] = ((const f32x4*)xr)[lane + 64 * j]; ss += (v[j].x * v[j].x + v[j].y * v[j].y) + (v[j].z * v[j].z + v[j].w * v[j].w); }
        ss = wave_sum(ss);
        const float rstd = 1.0f / sqrtf(ss * (1.0f / 1024.0f) + 1e-6f);
#pragma unroll
        for (int j = 0; j < 4; ++j) {
            if (copy) ((f32x4*)(copy + (long)row * 1024))[lane + 64 * j] = v[j];
            const f32x4 gg = ((const f32x4*)g)[lane + 64 * j];
            const f32x4 o = v[j] * rstd * gg;
            if (FINAL) ((f32x4*)(fdst + (long)row * 1024))[lane + 64 * j] = o;
            else { u32x2 w; w.x = pk2(o.x, o.y); w.y = pk2(o.z, o.w); ((u32x2*)(dst + (long)row * 1024))[lane + 64 * j] = w; }
        }
    }
}

DI void final_norm(const bf16_t* __restrict__ xb, const float* __restrict__ g, float* __restrict__ out, int wid, int lane) {
    asm volatile("" : "+v"(wid), "+v"(lane));
    for (int row = blockIdx.x * 8 + wid; row < T; row += gridDim.x * 8) {
        const u32x4 a = *(const u32x4*)(xb + (long)row * 1024 + lane * 16), b = *(const u32x4*)(xb + (long)row * 1024 + lane * 16 + 8);
        float v[16];
#pragma unroll
        for (int e = 0; e < 4; ++e) { v[2 * e] = bflo(a[e]); v[2 * e + 1] = bfhi(a[e]); v[8 + 2 * e] = bflo(b[e]); v[8 + 2 * e + 1] = bfhi(b[e]); }
        float ss = 0.f;
#pragma unroll
        for (int e = 0; e < 16; ++e) ss += v[e] * v[e];
        ss = wave_sum(ss);
        const float rstd = 1.0f / sqrtf(ss * (1.0f / 1024.0f) + 1e-6f);
#pragma unroll
        for (int q = 0; q < 4; ++q) {
            const f32x4 gg = *(const f32x4*)(g + lane * 16 + q * 4);
            f32x4 o; o.x = v[4 * q] * rstd * gg.x; o.y = v[4 * q + 1] * rstd * gg.y; o.z = v[4 * q + 2] * rstd * gg.z; o.w = v[4 * q + 3] * rstd * gg.w;
            *(f32x4*)(out + (long)row * 1024 + lane * 16 + q * 4) = o;
        }
    }
}

DI void spatial_phase(const bf16_t* __restrict__ z, const bf16_t* __restrict__ wsb, const float* __restrict__ vgain, const float* __restrict__ bs,
                      bf16_t* __restrict__ y, char* lds, int tid, int wid, int lane) {
    float* srstd = (float*)(lds + 65536);
    char* la = lds; char* lb = lds + 32768;
    for (int unit = blockIdx.x; unit < T / 64; unit += gridDim.x) {
        asm volatile("" : "+v"(tid)); wid = tid >> 6; lane = tid & 63;
        const int l31 = lane & 31, hh = lane >> 5;
        const int wr = wid >> 1, wc = wid & 1;
        const long t0 = (long)(unit >> 1) * 128;
        const int g0 = (unit & 1) * 4;
#pragma unroll
        for (int rb = 0; rb < 4; ++rb) {
            u32x4 va[4], vb[4];
#pragma unroll
            for (int r = 0; r < 4; ++r) {
                const bf16_t* vr = z + (t0 + wid * 16 + rb * 4 + r) * 2048 + 1024 + lane * 16;
                va[r] = *(const u32x4*)vr; vb[r] = *(const u32x4*)(vr + 8);
            }
#pragma unroll
            for (int r = 0; r < 4; ++r) {
                float ss = 0.f;
#pragma unroll
                for (int e = 0; e < 4; ++e) { const float x0 = bflo(va[r][e]), x1 = bfhi(va[r][e]), x2 = bflo(vb[r][e]), x3 = bfhi(vb[r][e]); ss += (x0 * x0 + x1 * x1) + (x2 * x2 + x3 * x3); }
                ss = wave_sum(ss);
                if (lane == 0) srstd[wid * 16 + rb * 4 + r] = 1.0f / sqrtf(ss * (1.0f / 1024.0f) + 1e-6f);
            }
        }
        __syncthreads();
        for (int g = g0; g < g0 + 4; ++g) {
#pragma unroll
            for (int i = 0; i < 4; ++i) {
                const int id = tid + NTH * i, row = id >> 4, ch = id & 15;
                const u32x4 w = *(const u32x4*)(wsb + (long)(g * 128 + row) * 128 + ch * 8);
                *(u32x4*)(la + (ch >> 3) * 16384 + swz(row, ch & 7)) = w;
                const int q = row, d0 = ch * 8;
                const u32x4 vv = *(const u32x4*)(z + (t0 + q) * 2048 + 1024 + g * 128 + d0);
                const float rsq = srstd[q];
                const f32x4 g0 = *(const f32x4*)(vgain + g * 128 + d0), g1 = *(const f32x4*)(vgain + g * 128 + d0 + 4);
                float vals[8];
                vals[0] = bflo(vv.x) * rsq * g0.x; vals[1] = bfhi(vv.x) * rsq * g0.y; vals[2] = bflo(vv.y) * rsq * g0.z; vals[3] = bfhi(vv.y) * rsq * g0.w;
                vals[4] = bflo(vv.z) * rsq * g1.x; vals[5] = bfhi(vv.z) * rsq * g1.y; vals[6] = bflo(vv.w) * rsq * g1.z; vals[7] = bfhi(vv.w) * rsq * g1.w;
                char* dstb = lb + (q >> 6) * 16384 + (q & 7) * 2;
                const int qc = (q & 63) >> 3;
#pragma unroll
                for (int e = 0; e < 8; ++e) *(bf16_t*)(dstb + swz(d0 + e, qc)) = bf1(vals[e]);
            }
            __syncthreads();
            f32x16 acc[2];
#pragma unroll
            for (int n = 0; n < 2; ++n)
#pragma unroll
                for (int i = 0; i < 16; ++i) acc[n][i] = 0.f;
#pragma unroll
            for (int kh = 0; kh < 2; ++kh)
#pragma unroll
                for (int s = 0; s < 4; ++s) {
                    const bf16x8 af = ldfrag(la + kh * 16384, wr * 32 + l31, 2 * s + hh);
#pragma unroll
                    for (int n = 0; n < 2; ++n) { const bf16x8 bfr = ldfrag(lb + kh * 16384, wc * 64 + n * 32 + l31, 2 * s + hh); acc[n] = MFMA(af, bfr, acc[n]); }
                }
#pragma unroll
            for (int n = 0; n < 2; ++n)
#pragma unroll
                for (int i = 0; i < 16; ++i) {
                    const int p = wr * 32 + crow(i, hh), d = wc * 64 + n * 32 + l31;
                    const float val = acc[n][i] + bs[g * 128 + p];
                    const float uu = bflo((unsigned)z[(t0 + p) * 2048 + g * 128 + d]);
                    y[(t0 + p) * 1024 + g * 128 + d] = bf1(uu * val);
                }
            __syncthreads();
        }
    }
}

DI void attn_phase(const bf16_t* __restrict__ qb, const bf16_t* __restrict__ kb, const bf16_t* __restrict__ vt, bf16_t* __restrict__ ob,
                   const float* lq1, const float* lk1, const float* lq2, const float* lk2, const float* __restrict__ subg, float lam_init,
                   char* lds, int tid, int wid, int lane) {
    asm volatile("" : "+v"(tid)); wid = tid >> 6; lane = tid & 63;
    const int c = wid & 1, qs = wid >> 1, l31 = lane & 31, hh = lane >> 5;
    const float d1 = wave_sum(lq1[lane] * lk1[lane]), d2 = wave_sum(lq2[lane] * lk2[lane]);
    const float lam = expf(d1) - expf(d2) + lam_init;
    const int srow = tid >> 3, sch = tid & 7;
    const int wv = __builtin_amdgcn_readfirstlane(tid >> 6);
    LAS char* l3 = (LAS char*)lds;
    for (int u = blockIdx.x; u < 5120; u += gridDim.x) {
        int seq, head, qblk;
        if (u < 4096) { const int r = u >> 8, b = u & 255, x = b & 7, lb = b >> 3, p = (r >> 1) * 8 + x; seq = 4 + (p >> 3); head = p & 7; qblk = (r & 1) * 32 + lb; }
        else { const int v = u - 4096, r = v >> 8, b = v & 255, x = b & 7, lb = b >> 3, p = r * 8 + x; seq = p >> 3; head = p & 7; qblk = lb; }
        const int S = seq < 4 ? 4096 : 8192;
        const long t0 = seq < 4 ? (long)seq * 4096 : (long)TP + (long)(seq - 4) * 8192;
        const long qrow_t = t0 + qblk * 128 + qs * 32 + l31;
        bf16x8 qf[4];
        {
            const bf16_t* qrow = qb + qrow_t * 1024 + (head * 2 + c) * 64 + 8 * hh;
#pragma unroll
            for (int s = 0; s < 4; ++s) qf[s] = *(const bf16x8*)(qrow + 16 * s);
        }
        const int cl = sch ^ ((srow >> 1) & 7);
        const bf16_t* kp = kb + (t0 + srow) * 1024 + head * 128 + cl * 8;
        const bf16_t* vp = vt + t0 * 1024 + ((long)head * 128 + srow) * S + cl * 8;
        const int nkt = S / 64;
#define ATT_ISSUE(KT, ST) do { const int kt_ = (KT) < nkt ? (KT) : nkt - 1; LAS char* st_ = l3 + (ST) * 32768 + wv * 1024; \
            const bf16_t* kq_ = kp + (long)kt_ * 64 * 1024; const bf16_t* vq_ = vp + kt_ * 64; \
            __builtin_amdgcn_global_load_lds((const GAS unsigned*)kq_, (LAS unsigned*)st_, 16, 0, 0); \
            __builtin_amdgcn_global_load_lds((const GAS unsigned*)(kq_ + 64), (LAS unsigned*)(st_ + 8192), 16, 0, 0); \
            __builtin_amdgcn_global_load_lds((const GAS unsigned*)vq_, (LAS unsigned*)(st_ + 16384), 16, 0, 0); \
            __builtin_amdgcn_global_load_lds((const GAS unsigned*)(vq_ + (long)64 * S), (LAS unsigned*)(st_ + 24576), 16, 0, 0); } while (0)
        ATT_ISSUE(0, 0); ATT_ISSUE(1, 1); ATT_ISSUE(2, 2);
        f32x16 oacc[4];
#pragma unroll
        for (int ef = 0; ef < 4; ++ef)
#pragma unroll
            for (int i = 0; i < 16; ++i) oacc[ef][i] = 0.f;
        float l_run = 0.f;
        f32x16 negm;
#pragma unroll
        for (int i = 0; i < 16; ++i) negm[i] = 0.f;
        for (int kt = 0; kt < nkt; ++kt) {
            asm volatile("s_waitcnt vmcnt(8)" ::: "memory");
            asm volatile("s_waitcnt lgkmcnt(0)" ::: "memory"); __builtin_amdgcn_s_barrier();
            ATT_ISSUE(kt + 3, (kt + 3) & 3);
            const char* cur = lds + (kt & 3) * 32768;
            const char* kl = cur + c * 8192; const char* vl = cur + 16384;
            f32x16 sacc[2];
            {
                bf16x8 kfr[2][4];
#pragma unroll
                for (int kf = 0; kf < 2; ++kf)
#pragma unroll
                    for (int s = 0; s < 4; ++s) kfr[kf][s] = ldfrag(kl, kf * 32 + l31, 2 * s + hh);
#pragma unroll
                for (int kf = 0; kf < 2; ++kf) {
                    sacc[kf] = MFMA(kfr[kf][0], qf[0], negm);
#pragma unroll
                    for (int s = 1; s < 4; ++s) sacc[kf] = MFMA(kfr[kf][s], qf[s], sacc[kf]);
                }
            }
            bf16x8 vf[2][4];
#pragma unroll
            for (int ef = 0; ef < 4; ++ef) vf[0][ef] = ldfrag(vl, ef * 32 + l31, hh);
            __builtin_amdgcn_sched_group_barrier(0x100, 4, 0);
#pragma unroll
            for (int g_ = 0; g_ < 4; ++g_) { __builtin_amdgcn_sched_group_barrier(0x008, 1, 0); __builtin_amdgcn_sched_group_barrier(0x100, 1, 0); }
            __builtin_amdgcn_sched_group_barrier(0x008, 4, 0);
            __builtin_amdgcn_sched_group_barrier(0x100, 4, 0);
            float mx = fmaxf(fmaxf(sacc[0][0], sacc[0][1]), sacc[0][2]);
#pragma unroll
            for (int i = 3; i < 15; i += 2) mx = fmaxf(fmaxf(mx, sacc[0][i]), sacc[0][i + 1]);
            mx = fmaxf(fmaxf(mx, sacc[0][15]), sacc[1][0]);
#pragma unroll
            for (int i = 1; i < 15; i += 2) mx = fmaxf(fmaxf(mx, sacc[1][i]), sacc[1][i + 1]);
            mx = fmaxf(mx, sacc[1][15]);
            if (kt == 0 || __any(mx > 8.0f)) {
                const float mfull = fmaxf(mx, __shfl_xor(mx, 32));
                const float delta = kt == 0 ? mfull : fmaxf(mfull, 0.f);
                const float alpha = kt == 0 ? 1.0f : __builtin_amdgcn_exp2f(-delta);
                l_run *= alpha;
#pragma unroll
                for (int ef = 0; ef < 4; ++ef)
#pragma unroll
                    for (int i = 0; i < 16; ++i) oacc[ef][i] *= alpha;
#pragma unroll
                for (int i = 0; i < 16; ++i) { negm[i] -= delta; sacc[0][i] -= delta; sacc[1][i] -= delta; }
            }
            float ps = 0.f;
            bf16x8 pq[4];
#define ATT_SOFTQ(Q) do { const int kf_ = (Q) >> 1, s2_ = (Q) & 1; \
                _Pragma("unroll") for (int i = 0; i < 8; ++i) { const float p_ = __builtin_amdgcn_exp2f(sacc[kf_][8 * s2_ + i]); ps += p_; sacc[kf_][8 * s2_ + i] = p_; } \
                u32x4 w_; w_.x = pk2(sacc[kf_][8 * s2_ + 0], sacc[kf_][8 * s2_ + 1]); w_.y = pk2(sacc[kf_][8 * s2_ + 2], sacc[kf_][8 * s2_ + 3]); \
                w_.z = pk2(sacc[kf_][8 * s2_ + 4], sacc[kf_][8 * s2_ + 5]); w_.w = pk2(sacc[kf_][8 * s2_ + 6], sacc[kf_][8 * s2_ + 7]); \
                pq[Q] = __builtin_bit_cast(bf16x8, w_); } while (0)
            ATT_SOFTQ(0);
#pragma unroll
            for (int q = 0; q < 4; ++q) {
                if (q < 3) {
#pragma unroll
                    for (int ef = 0; ef < 4; ++ef) vf[(q + 1) & 1][ef] = ldfrag(vl, ef * 32 + l31, ((q + 1) >> 1) * 4 + 2 * ((q + 1) & 1) + hh);
                    if (q == 0) ATT_SOFTQ(1); else if (q == 1) ATT_SOFTQ(2); else ATT_SOFTQ(3);
                }
#pragma unroll
                for (int ef = 0; ef < 4; ++ef) oacc[ef] = MFMA(vf[q & 1][ef], pq[q], oacc[ef]);
            }
            l_run += ps;
            __builtin_amdgcn_sched_group_barrier(0x002, 20, 0);
#pragma unroll
            for (int g_ = 0; g_ < 12; ++g_) { __builtin_amdgcn_sched_group_barrier(0x008, 1, 0); __builtin_amdgcn_sched_group_barrier(0x100, 1, 0); __builtin_amdgcn_sched_group_barrier(0x002, 5, 0); }
            __builtin_amdgcn_sched_group_barrier(0x008, 4, 0);
        }
        asm volatile("s_waitcnt vmcnt(0)" ::: "memory");
        __syncthreads();
        const float lt = l_run + __shfl_xor(l_run, 32);
        const float inv = 1.0f / lt;
        float* xch = (float*)lds;
        if (c == 1) {
#pragma unroll
            for (int ef = 0; ef < 4; ++ef)
#pragma unroll
                for (int i = 0; i < 16; ++i) xch[((qs * 4 + ef) * 16 + i) * 64 + lane] = oacc[ef][i] * inv;
        }
        __syncthreads();
        if (c == 0) {
            float ss = 0.f;
#pragma unroll
            for (int ef = 0; ef < 4; ++ef)
#pragma unroll
                for (int i = 0; i < 16; ++i) { const float o = oacc[ef][i] * inv - lam * xch[((qs * 4 + ef) * 16 + i) * 64 + lane]; oacc[ef][i] = o; ss += o * o; }
            ss += __shfl_xor(ss, 32);
            const float rstd = (1.0f - lam_init) / sqrtf(ss * (1.0f / 128.0f) + 1e-5f);
            bf16_t* orow = ob + qrow_t * 1024 + head * 128;
#pragma unroll
            for (int ef = 0; ef < 4; ++ef)
#pragma unroll
                for (int g4 = 0; g4 < 4; ++g4) {
                    const int e = ef * 32 + 8 * g4 + 4 * hh;
                    const f32x4 gv = *(const f32x4*)(subg + e);
                    u32x2 w;
                    w.x = pk2(oacc[ef][4 * g4 + 0] * rstd * gv.x, oacc[ef][4 * g4 + 1] * rstd * gv.y);
                    w.y = pk2(oacc[ef][4 * g4 + 2] * rstd * gv.z, oacc[ef][4 * g4 + 3] * rstd * gv.w);
                    *(u32x2*)(orow + e) = w;
                }
        }
        __syncthreads();
    }
}

DI void unpack8(const u32x4 a, float (&f)[8]) {
    f[0] = bflo(a.x); f[1] = bfhi(a.x); f[2] = bflo(a.y); f[3] = bfhi(a.y); f[4] = bflo(a.z); f[5] = bfhi(a.z); f[6] = bflo(a.w); f[7] = bfhi(a.w);
}
DI void ffn_fixup(const bf16_t* halo, const float* cw, const float* cb, bf16_t* act, int tid) {
    asm volatile("" : "+v"(tid));
    const int total = 319 * 2 * 352;
    for (int idx = blockIdx.x * NTH + tid; idx < total; idx += gridDim.x * NTH) {
        const int b = idx / 704, rem = idx - b * 704, which = rem >= 352 ? 1 : 0, jc = rem - which * 352;
        const int R0 = (b + 1) * 256;
        if (is_seq_start(R0)) continue;
        const int j0 = jc * 8;
        const int ng = (j0 >> 5) * 64 + (j0 & 31);
        const bf16_t* hp = halo + (long)(b * 4 + 2 + which) * 5632 + ng;
        float g[3][8], u[3][8];
#pragma unroll
        for (int t = 0; t < 3; ++t) {
            unpack8(*(const u32x4*)(hp + (long)t * 5632), g[t]);
            unpack8(*(const u32x4*)(hp + (long)t * 5632 + 32), u[t]);
        }
        float o[8];
#pragma unroll
        for (int e = 0; e < 8; ++e) {
            const int j = j0 + e;
            const float gg = cb[j] + cw[j] * g[0][e] + cw[5632 + j] * g[1][e] + cw[2 * 5632 + j] * g[2][e];
            const float uu = cb[2816 + j] + cw[2816 + j] * u[0][e] + cw[5632 + 2816 + j] * u[1][e] + cw[2 * 5632 + 2816 + j] * u[2][e];
            o[e] = gg * __builtin_amdgcn_rcpf(1.0f + __builtin_amdgcn_exp2f(-1.4426950408889634f * gg)) * uu;
        }
        u32x4 w; w.x = pk2(o[0], o[1]); w.y = pk2(o[2], o[3]); w.z = pk2(o[4], o[5]); w.w = pk2(o[6], o[7]);
        *(u32x4*)(act + (long)(R0 - 1 + which) * 2816 + j0) = w;
    }
}

DI float dot8(const u32x4 a, const u32x4 b) {
    float s = 0.f;
#pragma unroll
    for (int e = 0; e < 4; ++e) s += bflo(a[e]) * bflo(b[e]) + bfhi(a[e]) * bfhi(b[e]);
    return s;
}
DI void ffn_fixup2(const bf16_t* __restrict__ hb, const bf16_t* __restrict__ wfin, const float* __restrict__ cw, const float* __restrict__ cb, bf16_t* __restrict__ act, int tid) {
    asm volatile("" : "+v"(tid));
    const int total = 319 * 2 * 2816;
    for (int idx = blockIdx.x * NTH + tid; idx < total; idx += gridDim.x * NTH) {
        const int b = idx / 5632, rem = idx % 5632, which = rem / 2816, j = rem % 2816;
        const int R0 = (b + 1) * 256;
        if (is_seq_start(R0)) continue;
        const int ng = (j >> 5) * 64 + (j & 31), nu = ng + 32;
        const int r = R0 - 1 + which;
        const bf16_t* h0 = hb + (long)(r - 1) * 1024; const bf16_t* h1 = h0 + 1024; const bf16_t* h2 = h1 + 1024;
        const bf16_t* wgp = wfin + (long)ng * 1024; const bf16_t* wup = wfin + (long)nu * 1024;
        float ag0 = 0.f, ag1 = 0.f, ag2 = 0.f, au0 = 0.f, au1 = 0.f, au2 = 0.f;
        for (int k = 0; k < 1024; k += 8) {
            const u32x4 x0 = *(const u32x4*)(h0 + k), x1 = *(const u32x4*)(h1 + k), x2 = *(const u32x4*)(h2 + k);
            const u32x4 g8 = *(const u32x4*)(wgp + k), u8 = *(const u32x4*)(wup + k);
            ag0 += dot8(x0, g8); ag1 += dot8(x1, g8); ag2 += dot8(x2, g8);
            au0 += dot8(x0, u8); au1 += dot8(x1, u8); au2 += dot8(x2, u8);
        }
        const float g = cb[j] + cw[j] * ag0 + cw[5632 + j] * ag1 + cw[2 * 5632 + j] * ag2;
        const float u = cb[2816 + j] + cw[2816 + j] * au0 + cw[5632 + 2816 + j] * au1 + cw[2 * 5632 + 2816 + j] * au2;
        const float sg = g * __builtin_amdgcn_rcpf(1.0f + __builtin_amdgcn_exp2f(-1.4426950408889634f * g));
        act[(long)r * 2816 + j] = bf1(sg * u);
    }
}


#define XB_TMO      128
#define XB_XCNT(j)  (256  + 64 * (j))
#define XB_XSUB(j)  (1280 + 64 * (j))
#define XB_XGEN(j)  (2304 + 64 * (j))
#define XB_TOP      3328
#define XB_TOPGEN   3392
#define XCD_BAR_WORDS 3456
#define XB_SPIN_CAP (1u << 18)
DI unsigned xb_ld(unsigned* p)              { return __hip_atomic_load(p, __ATOMIC_RELAXED, __HIP_MEMORY_SCOPE_AGENT); }
DI unsigned xb_add(unsigned* p, unsigned v) { return __hip_atomic_fetch_add(p, v, __ATOMIC_RELAXED, __HIP_MEMORY_SCOPE_AGENT); }
DI unsigned xb_xcc_id() { return (unsigned)__builtin_amdgcn_s_getreg((3 << 11) | 20) & 0xFu; }
#define XB_SPIN(cond, bar) do { unsigned _sp = 0; while (cond) { __builtin_amdgcn_s_sleep(1); \
    if ((++_sp & 255u) == 0u) { if (xb_ld(&(bar)[XB_TMO])) break; if (_sp > XB_SPIN_CAP) { atomicAdd(&(bar)[XB_TMO], 1u); break; } } } } while (0)
struct XcdBarrier { unsigned* bar; unsigned x; volatile LAS unsigned* st; };
DI XcdBarrier xcd_barrier_post(unsigned* bar, volatile LAS unsigned* st) {
    XcdBarrier b; b.bar = bar; b.x = xb_xcc_id(); b.st = st;
    if (threadIdx.x == 0) (void)xb_add(&bar[XB_XCNT(b.x)], 1u);
    return b;
}
DI void xcd_barrier_complete(unsigned* bar, unsigned x, unsigned& nloc, unsigned& nx) {
    const unsigned G = gridDim.x * gridDim.y * gridDim.z;
    unsigned sum, cnt, mine, sp = 0u;
    for (;;) {
        sum = 0u; cnt = 0u; mine = 0u;
#pragma unroll
        for (unsigned j = 0; j < 16; ++j) { const unsigned c = xb_ld(&bar[XB_XCNT(j)]); sum += c; cnt += (c > 0u) ? 1u : 0u; mine = (j == x) ? c : mine; }
        if (sum == G) break;
        __builtin_amdgcn_s_sleep(1);
        if ((++sp & 255u) == 0u) { if (xb_ld(&bar[XB_TMO])) break; if (sp > XB_SPIN_CAP) { atomicAdd(&bar[XB_TMO], 1u); break; } }
    }
    nloc = mine > 0u ? mine : 1u; nx = cnt > 0u ? cnt : 1u;
}
DI void xcd_barrier(const XcdBarrier& b) {
    asm volatile("s_waitcnt vmcnt(0)" ::: "memory");
    __syncthreads();
    if (threadIdx.x == 0) {
        unsigned* bar = b.bar;
        __builtin_amdgcn_s_waitcnt(0);
        unsigned nloc = b.st[0], nx = b.st[1];
        if (nloc == 0u) { xcd_barrier_complete(bar, b.x, nloc, nx); b.st[0] = nloc; b.st[1] = nx; }
        const unsigned old = xb_add(&bar[XB_XSUB(b.x)], 1u);
        const unsigned gen = old / nloc;
        if (old + 1u == (gen + 1u) * nloc) {
            __builtin_amdgcn_fence(__ATOMIC_RELEASE, "agent");
            asm volatile("s_waitcnt vmcnt(0)" ::: "memory");
            const unsigned og = xb_add(&bar[XB_TOP], 1u);
            const unsigned tg = og / nx;
            if (og + 1u == (tg + 1u) * nx) xb_add(&bar[XB_TOPGEN], 1u);
            else XB_SPIN(xb_ld(&bar[XB_TOPGEN]) == tg, bar);
            __builtin_amdgcn_fence(__ATOMIC_ACQUIRE, "agent");
            xb_add(&bar[XB_XGEN(b.x)], 1u);
            asm volatile("s_waitcnt vmcnt(0)" ::: "memory");
        } else {
            XB_SPIN(xb_ld(&bar[XB_XGEN(b.x)]) == gen, bar);
            __builtin_amdgcn_fence(__ATOMIC_ACQUIRE, "agent");
            asm volatile("s_waitcnt vmcnt(0)" ::: "memory");
        }
    }
    __syncthreads();
}
#define GSYNC_CG() do { asm volatile("s_waitcnt vmcnt(0)" ::: "memory"); grid.sync(); } while (0)
#define GSYNC() do { XcdBarrier xb_; xb_.bar = (unsigned*)(p.ws + OFF_BAR); xb_.x = xb_xcc_id(); xb_.st = (volatile LAS unsigned*)((LAS char*)lds + XB_LDS_OFF); xcd_barrier(xb_); } while (0)
__global__ void __launch_bounds__(512) mega(Params p) {
    extern __shared__ __attribute__((aligned(16))) char lds[];
    cg::grid_group grid = cg::this_grid();
    const int tid = threadIdx.x, wid = tid >> 6, lane = tid & 63;
    char* ws = p.ws;
    if (tid < 4) ((volatile LAS unsigned*)((LAS char*)lds + XB_LDS_OFF))[tid] = 0u;
    __syncthreads();
    (void)xcd_barrier_post((unsigned*)(ws + OFF_BAR), (volatile LAS unsigned*)((LAS char*)lds + XB_LDS_OFF));
    bf16_t* w_gin = (bf16_t*)(ws + OFF_GIN); bf16_t* w_gout = (bf16_t*)(ws + OFF_GOUT); bf16_t* w_gs = (bf16_t*)(ws + OFF_GS);
    bf16_t* w_qkv = (bf16_t*)(ws + OFF_QKV); bf16_t* w_dout = (bf16_t*)(ws + OFF_DOUT); bf16_t* w_fin = (bf16_t*)(ws + OFF_FIN); bf16_t* w_fout = (bf16_t*)(ws + OFF_FOUT);
    f32x2* rope = (f32x2*)(ws + OFF_ROPE);
    bf16_t* hb = (bf16_t*)(ws + OFF_H); bf16_t* big = (bf16_t*)(ws + OFF_BIG); bf16_t* halo = (bf16_t*)(ws + OFF_HALO);
    bf16_t* yo = (bf16_t*)p.out;

    bf16_t* hb2 = (bf16_t*)(ws + OFF_H2); float* ssq = (float*)(ws + OFF_SSQ);
    for (int j = 0; j < 2; ++j) {
        convert_T(p.in[5] + (long)j * 1024 * 2048, 1024, 2048, w_gin + (long)j * 2048 * 1024, false, p.in[2] + (2 * j) * 1024, lds, tid);
        convert_T(p.in[9] + (long)j * 1024 * 1024, 1024, 1024, w_gout + (long)j * 1024 * 1024, false, nullptr, lds, tid);
        convert_T(p.in[10] + (long)j * 1024 * 3072, 1024, 3072, w_qkv + (long)j * 3072 * 1024, false, p.in[2] + (2 * j + 1) * 1024, lds, tid);
        convert_T(p.in[16] + (long)j * 1024 * 1024, 1024, 1024, w_dout + (long)j * 1024 * 1024, false, nullptr, lds, tid);
    }
    for (int j = 0; j < 4; ++j) {
        convert_T(p.in[17] + (long)j * 1024 * 5632, 1024, 5632, w_fin + (long)j * 5632 * 1024, true, p.in[3] + j * 1024, lds, tid);
        convert_T(p.in[20] + (long)j * 2816 * 1024, 2816, 1024, w_fout + (long)j * 1024 * 2816, false, nullptr, lds, tid);
    }
    for (int idx = blockIdx.x * NTH + tid; idx < 2 * 8 * 128 * 128; idx += gridDim.x * NTH) w_gs[idx] = bf1(p.in[7][idx]);
    for (int idx = blockIdx.x * NTH + tid; idx < 8192 * 32; idx += gridDim.x * NTH) {
        const int pos = idx >> 5, i = idx & 31;
        const float ang = (float)pos * p.inv_freq[i];
        const double a = (double)ang;
        const double n = rint(a * 0.15915494309189535);
        double r = fma(-n, 6.283185307179586, a);
        r = fma(-n, 2.4492935982947064e-16, r);
        const float rf = (float)r;
        f32x2 cs; cs.x = cosf(rf); cs.y = sinf(rf);
        rope[idx] = cs;
    }
    for (int row = blockIdx.x * 8 + wid; row < T; row += gridDim.x * 8) {
        const float* xr = row < TP ? p.in[0] + (long)row * 1024 : p.in[1] + (long)(row - TP) * 1024;
        float ss = 0.f;
#pragma unroll
        for (int jj = 0; jj < 4; ++jj) {
            const f32x4 v = ((const f32x4*)xr)[lane + 64 * jj];
            u32x2 w; w.x = pk2(v.x, v.y); w.y = pk2(v.z, v.w);
            ((u32x2*)(hb + (long)row * 1024))[lane + 64 * jj] = w;
            const float a0 = bflo(w.x), a1 = bfhi(w.x), a2 = bflo(w.y), a3 = bfhi(w.y);
            ss += (a0 * a0 + a1 * a1) + (a2 * a2 + a3 * a3);
        }
        ss = wave_sum(ss);
        if (lane == 0) { f32x4 q = {ss, 0.f, 0.f, 0.f}; *(f32x4*)(ssq + (long)row * 4) = q; }
    }
    GSYNC_CG();

    for (int layer = 0; layer < 4; ++layer) {
        const int j = layer >> 1;
        char* wsl = p.ws; asm volatile("" : "+s"(wsl));
        bf16_t* w_gin = (bf16_t*)(wsl + OFF_GIN); bf16_t* w_gout = (bf16_t*)(wsl + OFF_GOUT); bf16_t* w_gs = (bf16_t*)(wsl + OFF_GS);
        bf16_t* w_qkv = (bf16_t*)(wsl + OFF_QKV); bf16_t* w_dout = (bf16_t*)(wsl + OFF_DOUT); bf16_t* w_fin = (bf16_t*)(wsl + OFF_FIN); bf16_t* w_fout = (bf16_t*)(wsl + OFF_FOUT);
        f32x2* rope = (f32x2*)(wsl + OFF_ROPE);
        bf16_t* hb = (bf16_t*)(wsl + OFF_H); bf16_t* big = (bf16_t*)(wsl + OFF_BIG); bf16_t* halo = (bf16_t*)(wsl + OFF_HALO);
        bf16_t* hb2 = (bf16_t*)(wsl + OFF_H2); float* ssq = (float*)(wsl + OFF_SSQ);
        bf16_t* yo = (bf16_t*)p.out; asm volatile("" : "+s"(yo));
        if ((layer & 1) == 0) {
            { EpiGelu e{big}; gemm_phase(hb, 1024, w_gin + (long)j * 2048 * 1024, 1024, 2048, 1024, e, ssq, lds, tid); }
            GSYNC();
            spatial_phase(big, w_gs + (long)j * 8 * 128 * 128, p.in[6] + j * 1024, p.in[8] + j * 1024, yo, lds, tid, wid, lane);
            GSYNC();
            { EpiResid e{hb, hb2, ssq}; gemm_phase(yo, 1024, w_gout + (long)j * 1024 * 1024, 1024, 1024, 1024, e, ssq, lds, tid); }
            GSYNC();
        } else {
            bf16_t* qb = big; bf16_t* kb = big + (long)T * 1024; bf16_t* vt = big + (long)T * 2048;
            { EpiQkv e{qb, kb, vt, rope}; gemm_phase(hb, 1024, w_qkv + (long)j * 3072 * 1024, 1024, 3072, 1024, e, ssq, lds, tid); }
            GSYNC();
            const float lam_init = 0.8f - 0.6f * expf(-0.3f * (float)layer);
            attn_phase(qb, kb, vt, yo, p.in[11] + j * 64, p.in[12] + j * 64, p.in[13] + j * 64, p.in[14] + j * 64, p.in[15] + j * 128, lam_init, lds, tid, wid, lane);
            GSYNC();
            { EpiResid e{hb, hb2, ssq}; gemm_phase(yo, 1024, w_dout + (long)j * 1024 * 1024, 1024, 1024, 1024, e, ssq, lds, tid); }
            GSYNC();
        }
        { EpiFfn e{p.in[18] + (long)layer * 3 * 5632, p.in[19] + (long)layer * 5632, big, halo};
          gemm_phase(hb2, 1024, w_fin + (long)layer * 5632 * 1024, 1024, 5632, 1024, e, ssq, lds, tid); }
        GSYNC();
        ffn_fixup(halo, p.in[18] + (long)layer * 3 * 5632, p.in[19] + (long)layer * 5632, big, tid);
        GSYNC();
        { EpiResid e{hb2, hb, ssq}; gemm_phase(big, 2816, w_fout + (long)layer * 1024 * 2816, 2816, 1024, 2816, e, ssq, lds, tid); }
        GSYNC();
    }
    {
        int t_end = threadIdx.x; asm volatile("" : "+v"(t_end));
        char* wse = p.ws; asm volatile("" : "+s"(wse));
        final_norm((const bf16_t*)(wse + OFF_H), p.in[4], p.out, t_end >> 6, t_end & 63);
    }
}

extern "C" void kernel_launch(void* const* d_in, const int* in_sizes, int n_in, void* d_out, int out_size, void* d_ws, size_t ws_size,
                              hipStream_t stream) {
    static int grid_blocks = 0;
    if (grid_blocks == 0) {
        if (n_in != 21 || out_size != T * D || ws_size < WS_END) { fprintf(stderr, "kernel_launch: unexpected sizes n_in %d out %d ws %zu (need %zu)\n", n_in, out_size, ws_size, (size_t)WS_END); grid_blocks = -1; return; }
        int dev = 0, cus = 0, per_cu = 0;
        hipGetDevice(&dev);
        hipDeviceGetAttribute(&cus, hipDeviceAttributeMultiprocessorCount, dev);
        hipFuncSetAttribute((const void*)mega, hipFuncAttributeMaxDynamicSharedMemorySize, LDS_BYTES);
        hipOccupancyMaxActiveBlocksPerMultiprocessor(&per_cu, (const void*)mega, NTH, LDS_BYTES);
        if (per_cu < 1) { fprintf(stderr, "kernel_launch: occupancy query says %d blocks/CU\n", per_cu); per_cu = 1; }
        grid_blocks = cus * per_cu;
        (void)hipGetLastError();
    }
    if (grid_blocks < 0) return;
    Params p{};
    for (int i = 0; i < 21; ++i) p.in[i] = (const float*)d_in[i];
    p.out = (float*)d_out; p.ws = (char*)d_ws;
    for (int i = 0; i < 32; ++i) p.inv_freq[i] = (float)pow(10000.0, -(double)i / 32.0);
    (void)hipMemsetAsync((char*)d_ws + OFF_BAR, 0, 3456 * 4, stream);
    void* args[] = {&p};
    hipError_t e = hipLaunchCooperativeKernel((const void*)mega, dim3(grid_blocks), dim3(NTH), args, LDS_BYTES, stream);
    if (e != hipSuccess) fprintf(stderr, "cooperative launch failed: %s (grid %d)\n", hipGetErrorString(e), grid_blocks);
}
```

```cpp
#include <hip/hip_runtime.h>
#include <hip/hip_cooperative_groups.h>
#include <cmath>
#include <cstdio>
namespace cg = cooperative_groups;

typedef unsigned short bf16_t;
typedef short bf16x8 __attribute__((ext_vector_type(8)));
typedef float f32x16 __attribute__((ext_vector_type(16)));
typedef float f32x4 __attribute__((ext_vector_type(4)));
typedef float f32x2 __attribute__((ext_vector_type(2)));
typedef unsigned u32x4 __attribute__((ext_vector_type(4)));
typedef unsigned u32x2 __attribute__((ext_vector_type(2)));
typedef __bf16 bf16x2_t __attribute__((ext_vector_type(2)));

#define DI __device__ __forceinline__
#define MFMA(a, b, c) __builtin_amdgcn_mfma_f32_32x32x16_bf16((a), (b), (c), 0, 0, 0)
#define MFMA16(a, b, c) __builtin_amdgcn_mfma_f32_16x16x32_bf16((a), (b), (c), 0, 0, 0)
typedef f32x4 gacc_t[8][4];

constexpr int T = 81920, TP = 16384, D = 1024, NTH = 512;
constexpr int XB_LDS_OFF = 256 * 528 + 1024;
constexpr int LDS_BYTES = 256 * 528 + 1024 + 16;

constexpr size_t OFF_GIN = 0;
constexpr size_t OFF_GOUT = OFF_GIN + 2ull * 2048 * 1024 * 2;
constexpr size_t OFF_GS = OFF_GOUT + 2ull * 1024 * 1024 * 2;
constexpr size_t OFF_QKV = OFF_GS + 2ull * 8 * 128 * 128 * 2;
constexpr size_t OFF_DOUT = OFF_QKV + 2ull * 3072 * 1024 * 2;
constexpr size_t OFF_FIN = OFF_DOUT + 2ull * 1024 * 1024 * 2;
constexpr size_t OFF_FOUT = OFF_FIN + 4ull * 5632 * 1024 * 2;
constexpr size_t OFF_ROPE = OFF_FOUT + 4ull * 1024 * 2816 * 2;
constexpr size_t OFF_H = OFF_ROPE + 8192ull * 32 * 8;
constexpr size_t OFF_BIG = OFF_H + (size_t)T * 1024 * 2;
constexpr size_t OFF_HALO = OFF_BIG + (size_t)T * 3072 * 2;
constexpr size_t OFF_H2 = OFF_HALO + 320ull * 4 * 5632 * 2;
constexpr size_t OFF_SSQ = OFF_H2 + (size_t)T * 1024 * 2;
constexpr size_t OFF_BAR = OFF_SSQ + (size_t)T * 4 * 4;
constexpr size_t WS_END = OFF_BAR + 3456 * 4;
constexpr int RSTD_OFF = 256 * 528;

struct Params {
    const float* in[21];
    float* out;
    char* ws;
    float inv_freq[32];
};

DI unsigned pk2(float a, float b) { f32x2 v = {a, b}; bf16x2_t r = __builtin_convertvector(v, bf16x2_t); return __builtin_bit_cast(unsigned, r); }
DI bf16_t bf1(float a) { return (bf16_t)(pk2(a, 0.f) & 0xffffu); }
DI float bflo(unsigned w) { return __uint_as_float(w << 16); }
DI float bfhi(unsigned w) { return __uint_as_float(w & 0xffff0000u); }
DI float wave_sum(float v) {
#pragma unroll
    for (int o = 1; o < 64; o <<= 1) v += __shfl_xor(v, o);
    return v;
}
DI int crow(int i, int h) { return (i & 3) + 8 * (i >> 2) + 4 * h; }
DI int swz(int row, int chunk) { return row * 128 + ((chunk ^ ((row >> 1) & 7)) << 4); }
DI bf16x8 ldfrag(const char* lds, int row, int chunk) { return *(const bf16x8*)(lds + swz(row, chunk)); }
DI bool is_seq_start(int R) { return R < TP ? (R & 4095) == 0 : ((R - TP) & 8191) == 0; }

#define GAS __attribute__((address_space(1)))
#define LAS __attribute__((address_space(3)))
template <bool RSTD, bool SWAP>
DI void gemm_tile(gacc_t& acc, const bf16_t* __restrict__ A, int lda, const bf16_t* __restrict__ Bt, int ldb, int K,
                  char* lds, int tid, int wr, int wc, int lane, const float* ssq_row) {
#pragma unroll
    for (int m = 0; m < 8; ++m)
#pragma unroll
        for (int n = 0; n < 4; ++n)
#pragma unroll
            for (int j = 0; j < 4; ++j) acc[m][n][j] = 0.f;
    const int nk = K / 64;
    const int fr = lane & 15, fq = lane >> 4;
    const int srow = tid >> 3, sch = tid & 7;
    const int cl = sch ^ ((srow >> 1) & 7);
    const int wv = __builtin_amdgcn_readfirstlane(tid >> 6);
    const bf16_t* ap = A + (long)srow * lda + cl * 8;
    const bf16_t* bp = Bt + (long)srow * ldb + cl * 8;
    LAS char* l3 = (LAS char*)lds;
#define GEMM_ISSUE(KT, ST) do { \
        _Pragma("unroll") for (int i_ = 0; i_ < 4; ++i_) { \
            __builtin_amdgcn_global_load_lds((const GAS unsigned*)(ap + (long)(64 * i_) * lda + (KT) * 64), (LAS unsigned*)(l3 + (ST) * 65536 + i_ * 8192 + wv * 1024), 16, 0, 0); \
            __builtin_amdgcn_global_load_lds((const GAS unsigned*)(bp + (long)(64 * i_) * ldb + (KT) * 64), (LAS unsigned*)(l3 + (ST) * 65536 + 32768 + i_ * 8192 + wv * 1024), 16, 0, 0); \
        } } while (0)
    GEMM_ISSUE(0, 0);
    if (RSTD && tid < 256) {
        const f32x4 q = *(const f32x4*)ssq_row;
        ((float*)(lds + RSTD_OFF))[tid] = 1.0f / sqrtf(((q.x + q.y) + (q.z + q.w)) * (1.0f / 1024.0f) + 1e-6f);
    }
    asm volatile("s_waitcnt vmcnt(0)" ::: "memory");
    __syncthreads();
    for (int kt = 0; kt < nk; ++kt) {
        const char* cur = lds + (kt & 1) * 65536;
        if (kt + 1 < nk) GEMM_ISSUE(kt + 1, (kt + 1) & 1);
        bf16x8 bfr[2][4], afr[3];
#pragma unroll
        for (int n = 0; n < 4; ++n) bfr[0][n] = ldfrag(cur + 32768, wc * 64 + n * 16 + fr, fq);
        afr[0] = ldfrag(cur, wr * 128 + fr, fq);
        afr[1] = ldfrag(cur, wr * 128 + 16 + fr, fq);
#pragma unroll
        for (int idx = 0; idx < 16; ++idx) {
            const int ks = idx >> 3, m = idx & 7;
            if (idx < 14) afr[(idx + 2) % 3] = ldfrag(cur, wr * 128 + ((idx + 2) & 7) * 16 + fr, ((idx + 2) >> 3) * 4 + fq);
            if (ks == 0 && m >= 2 && m < 6) bfr[1][m - 2] = ldfrag(cur + 32768, wc * 64 + (m - 2) * 16 + fr, 4 + fq);
#pragma unroll
            for (int n = 0; n < 4; ++n) acc[m][n] = SWAP ? MFMA16(bfr[ks][n], afr[idx % 3], acc[m][n]) : MFMA16(afr[idx % 3], bfr[ks][n], acc[m][n]);
        }
        __builtin_amdgcn_sched_group_barrier(0x100, 6, 0);
#define GEMM_SG1() do { __builtin_amdgcn_sched_group_barrier(0x100, 1, 0); __builtin_amdgcn_sched_group_barrier(0x008, 4, 0); } while (0)
#define GEMM_SG2() do { __builtin_amdgcn_sched_group_barrier(0x100, 2, 0); __builtin_amdgcn_sched_group_barrier(0x008, 4, 0); } while (0)
        GEMM_SG1(); GEMM_SG1(); GEMM_SG2(); GEMM_SG2(); GEMM_SG2(); GEMM_SG2(); GEMM_SG1(); GEMM_SG1();
        GEMM_SG1(); GEMM_SG1(); GEMM_SG1(); GEMM_SG1(); GEMM_SG1(); GEMM_SG1();
        __builtin_amdgcn_sched_group_barrier(0x008, 8, 0);
        __builtin_amdgcn_sched_barrier(0);
        asm volatile("s_waitcnt vmcnt(0)" ::: "memory");
        __syncthreads();
    }
}

DI bool tile_order(int L, int nM, int nN, int& pm, int& pn) {
    const int nwg = nM * nN;
    if (L >= nwg) return false;
    int wgid = L;
    { const int q = nwg / 8, r = nwg % 8, xcd = wgid % 8, off = wgid / 8; wgid = (xcd < r ? xcd * (q + 1) : r * (q + 1) + (xcd - r) * q) + off; }
    const int nig = 8 * nN, gid = wgid / nig, fm = gid * 8, gsz = (nM - fm) < 8 ? (nM - fm) : 8;
    pm = fm + ((wgid % nig) % gsz); pn = (wgid % nig) / gsz;
    return true;
}

DI void store_tile_from_lds(const char* lds, bf16_t* dst, long ld, int tid) {
#pragma unroll
    for (int k = 0; k < 16; ++k) {
        const int id = tid + NTH * k, row = id >> 5, ch = id & 31;
        const u32x4 v = *(const u32x4*)(lds + row * 528 + ch * 16);
        *(u32x4*)(dst + (long)row * ld + ch * 8) = v;
    }
}
struct EpiGelu {
    static constexpr bool NEEDS_RSTD = true;
    static DI bool swap_tile(int) { return true; }
    bf16_t* z;
    DI void operator()(gacc_t& acc, int pm, int pn, char* lds, int tid, int wr, int wc, int lane) const {
        asm volatile("" : "+v"(tid), "+v"(lane));
        const int fr = lane & 15, fq = lane >> 4;
        char* lbase = lds + (wr * 128 + fr) * 528 + (wc * 64 + 4 * fq) * 2;
        const float* rl = (const float*)(lds + RSTD_OFF) + wr * 128 + fr;
#pragma unroll
        for (int m = 0; m < 8; ++m) {
            const float r = rl[m * 16];
#pragma unroll
            for (int n = 0; n < 4; ++n) {
                float g[4];
#pragma unroll
                for (int j = 0; j < 4; ++j) {
                    const float x = acc[m][n][j] * r;
                    const float u = 0.7978845608028654f * (x + 0.044715f * x * x * x);
                    const float e = __builtin_amdgcn_exp2f(-2.885390081777927f * u);
                    g[j] = x * __builtin_amdgcn_rcpf(1.0f + e);
                }
                u32x2 w; w.x = pk2(g[0], g[1]); w.y = pk2(g[2], g[3]);
                *(u32x2*)(lbase + m * 16 * 528 + n * 32) = w;
            }
            __builtin_amdgcn_sched_barrier(0);
        }
        __syncthreads();
        store_tile_from_lds(lds, z + (long)pm * 256 * 2048 + pn * 256, 2048, tid);
        __syncthreads();
    }
};
struct EpiResid {
    static constexpr bool NEEDS_RSTD = false;
    static DI bool swap_tile(int) { return true; }
    const bf16_t* xold; bf16_t* xnew; float* ssq;
    DI void operator()(gacc_t& acc, int pm, int pn, char* lds, int tid, int wr, int wc, int lane) const {
        asm volatile("" : "+v"(tid), "+v"(lane));
        const int fr = lane & 15, fq = lane >> 4, wid = tid >> 6;
        char* lbase = lds + (wr * 128 + fr) * 528 + (wc * 64 + 4 * fq) * 2;
#pragma unroll
        for (int m = 0; m < 8; ++m)
#pragma unroll
            for (int n = 0; n < 4; ++n) { u32x2 w; w.x = pk2(acc[m][n][0], acc[m][n][1]); w.y = pk2(acc[m][n][2], acc[m][n][3]); *(u32x2*)(lbase + m * 16 * 528 + n * 32) = w; }
        __builtin_amdgcn_sched_barrier(0);
        __syncthreads();
        __builtin_amdgcn_sched_barrier(0);
        const int g = lane >> 5, j32 = lane & 31;
#pragma unroll
        for (int ib = 0; ib < 4; ++ib) {
            __builtin_amdgcn_sched_barrier(0);
            u32x4 xv[4];
#pragma unroll
            for (int u = 0; u < 4; ++u) {
                const long row = (long)pm * 256 + (ib * 4 + u) * 16 + wid * 2 + g;
                xv[u] = *(const u32x4*)(xold + row * 1024 + pn * 256 + j32 * 8);
            }
#pragma unroll
            for (int u = 0; u < 4; ++u) {
                const int rloc = (ib * 4 + u) * 16 + wid * 2 + g;
                const long row = (long)pm * 256 + rloc;
                const u32x4 a = *(const u32x4*)(lds + rloc * 528 + j32 * 16);
                u32x4 w; float ss = 0.f;
#pragma unroll
                for (int e = 0; e < 4; ++e) {
                    w[e] = pk2(bflo(xv[u][e]) + bflo(a[e]), bfhi(xv[u][e]) + bfhi(a[e]));
                    const float b0 = bflo(w[e]), b1 = bfhi(w[e]);
                    ss += b0 * b0 + b1 * b1;
                }
                *(u32x4*)(xnew + row * 1024 + pn * 256 + j32 * 8) = w;
#pragma unroll
                for (int o = 1; o < 32; o <<= 1) ss += __shfl_xor(ss, o);
                if (j32 == 0) ssq[row * 4 + pn] = ss;
            }
        }
        __syncthreads();
    }
};
struct EpiQkv {
    static constexpr bool NEEDS_RSTD = true;
    static DI bool swap_tile(int) { return true; }
    bf16_t* qb; bf16_t* kb; bf16_t* vt; const f32x2* rope;
    DI void operator()(gacc_t& acc, int pm, int pn, char* lds, int tid, int wr, int wc, int lane) const {
        asm volatile("" : "+v"(tid), "+v"(lane));
        const int fr = lane & 15, fq = lane >> 4;
        const int R0 = pm * 256;
        const int t0 = R0 < TP ? (R0 & ~4095) : TP + ((R0 - TP) & ~8191);
        const int S = R0 < TP ? 4096 : 8192;
        char* lbase = lds + (wr * 128 + fr) * 528 + (wc * 64 + 4 * fq) * 2;
        const float* rlt = (const float*)(lds + RSTD_OFF) + wr * 128 + fr;
        if (pn < 8) {
            const float sc = pn < 4 ? 0.18033688011112042f : 1.0f;
            const f32x2* rbase = rope + (R0 - t0 + wr * 128 + fr) * 32 + 4 * fq;
#pragma unroll
            for (int m = 0; m < 8; ++m) {
                const float rs = rlt[m * 16] * sc;
#pragma unroll
                for (int n = 0; n < 2; ++n) {
                    const f32x4 c01 = *(const f32x4*)(rbase + m * 16 * 32 + n * 16), c23 = *(const f32x4*)(rbase + m * 16 * 32 + n * 16 + 2);
                    const float cs_[4] = {c01.x, c01.z, c23.x, c23.z}, sn_[4] = {c01.y, c01.w, c23.y, c23.w};
                    float o1[4], o2[4];
#pragma unroll
                    for (int j = 0; j < 4; ++j) {
                        const float x1 = acc[m][n][j], x2 = acc[m][n + 2][j];
                        o1[j] = (x1 * cs_[j] - x2 * sn_[j]) * rs; o2[j] = (x2 * cs_[j] + x1 * sn_[j]) * rs;
                    }
                    u32x2 w1, w2; w1.x = pk2(o1[0], o1[1]); w1.y = pk2(o1[2], o1[3]); w2.x = pk2(o2[0], o2[1]); w2.y = pk2(o2[2], o2[3]);
                    *(u32x2*)(lbase + m * 16 * 528 + n * 32) = w1; *(u32x2*)(lbase + m * 16 * 528 + n * 32 + 64) = w2;
                }
                __builtin_amdgcn_sched_barrier(0);
            }
        } else {
#pragma unroll
            for (int m = 0; m < 8; ++m) {
                const float r = rlt[m * 16];
#pragma unroll
                for (int n = 0; n < 4; ++n) { u32x2 w; w.x = pk2(acc[m][n][0] * r, acc[m][n][1] * r); w.y = pk2(acc[m][n][2] * r, acc[m][n][3] * r); *(u32x2*)(lbase + m * 16 * 528 + n * 32) = w; }
            }
        }
        __syncthreads();
        if (pn < 8) {
            store_tile_from_lds(lds, (pn < 4 ? qb : kb) + (long)R0 * 1024 + (pn & 3) * 256, 1024, tid);
        } else {
            const int e = tid & 255, gh = tid >> 8;
            const int cr = (pn - 8) * 256 + e, head = cr >> 7;
            bf16_t* vrow = vt + (long)t0 * 1024 + (long)(head * 128 + (cr & 127)) * S + (R0 - t0);
            const char* col = lds + e * 2;
#pragma unroll
            for (int g = 0; g < 4; ++g) {
                const int grp = gh * 4 + g;
                unsigned w[16];
#pragma unroll
                for (int pp = 0; pp < 16; ++pp) {
                    const int p0 = 2 * pp, p1 = 2 * pp + 1;
                    const int k0 = 16 * (p0 >> 4) + 8 * ((p0 >> 2) & 1) + 4 * ((p0 >> 3) & 1) + (p0 & 3), k1 = 16 * (p1 >> 4) + 8 * ((p1 >> 2) & 1) + 4 * ((p1 >> 3) & 1) + (p1 & 3);
                    const unsigned lo = *(const bf16_t*)(col + (grp * 32 + k0) * 528), hi = *(const bf16_t*)(col + (grp * 32 + k1) * 528);
                    w[pp] = lo | (hi << 16);
                }
#pragma unroll
                for (int q = 0; q < 4; ++q) { u32x4 o; o.x = w[4 * q]; o.y = w[4 * q + 1]; o.z = w[4 * q + 2]; o.w = w[4 * q + 3]; *(u32x4*)(vrow + grp * 32 + q * 8) = o; }
            }
        }
        __syncthreads();
    }
};
struct EpiFfn {
    static constexpr bool NEEDS_RSTD = true;
    static DI bool swap_tile(int) { return true; }
    const float* cw; const float* cb; bf16_t* act; bf16_t* halo;
    DI void operator()(gacc_t& acc, int pm, int pn, char* lds, int tid, int wr, int wc, int lane) const {
        asm volatile("" : "+v"(tid), "+v"(lane));
        const int fr = lane & 15, fq = lane >> 4;
        constexpr int RS = 528;
        const float* rl = (const float*)(lds + RSTD_OFF) + wr * 128 + fr;
        {
            char* lbase = lds + (wr * 128 + fr) * RS + (wc * 64 + 4 * fq) * 2;
            bf16_t* hrow = halo + (long)(pm * 4) * 5632 + pn * 256 + wc * 64 + 4 * fq;
#pragma unroll
            for (int m = 0; m < 8; ++m) {
                const float r = rl[m * 16];
#pragma unroll
                for (int n = 0; n < 4; ++n) {
                    u32x2 w; w.x = pk2(acc[m][n][0] * r, acc[m][n][1] * r); w.y = pk2(acc[m][n][2] * r, acc[m][n][3] * r);
                    *(u32x2*)(lbase + m * 16 * RS + n * 32) = w;
                    if (m == 0 && wr == 0 && fr < 2) *(u32x2*)(hrow + fr * 5632 + n * 16) = w;
                    if (m == 7 && wr == 1 && fr >= 14) *(u32x2*)(hrow + (fr - 12) * 5632 + n * 16) = w;
                }
            }
        }
        __syncthreads();
        const int cgp = tid & 15, rs = tid >> 4;
        const int jg = pn * 128 + cgp * 8;
        float wg[3][8], wu[3][8], bg[8], bu[8];
#pragma unroll
        for (int t = 0; t < 3; ++t) {
            const f32x4 a0 = *(const f32x4*)(cw + t * 5632 + jg), a1 = *(const f32x4*)(cw + t * 5632 + jg + 4);
            const f32x4 b0 = *(const f32x4*)(cw + t * 5632 + 2816 + jg), b1 = *(const f32x4*)(cw + t * 5632 + 2816 + jg + 4);
#pragma unroll
            for (int e = 0; e < 4; ++e) { wg[t][e] = a0[e]; wg[t][4 + e] = a1[e]; wu[t][e] = b0[e]; wu[t][4 + e] = b1[e]; }
        }
        {
            const f32x4 a0 = *(const f32x4*)(cb + jg), a1 = *(const f32x4*)(cb + jg + 4);
            const f32x4 b0 = *(const f32x4*)(cb + 2816 + jg), b1 = *(const f32x4*)(cb + 2816 + jg + 4);
#pragma unroll
            for (int e = 0; e < 4; ++e) { bg[e] = a0[e]; bg[4 + e] = a1[e]; bu[e] = b0[e]; bu[4 + e] = b1[e]; }
        }
        const char* gbase = lds + ((cgp >> 2) * 64 + (cgp & 3) * 8) * 2;
        const int R0 = pm * 256;
        const bool first = is_seq_start(R0), last = is_seq_start(R0 + 256);
        float pg[8], pu[8], cg_[8], cu[8];
        const int r0 = rs * 8;
        auto ldrow = [&](int row, float (&g)[8], float (&u)[8]) {
            if (row < 0 || row > 255) {
#pragma unroll
                for (int e = 0; e < 8; ++e) { g[e] = 0.f; u[e] = 0.f; }
            } else {
                const u32x4 a = *(const u32x4*)(gbase + row * RS), b = *(const u32x4*)(gbase + row * RS + 64);
                g[0] = bflo(a.x); g[1] = bfhi(a.x); g[2] = bflo(a.y); g[3] = bfhi(a.y); g[4] = bflo(a.z); g[5] = bfhi(a.z); g[6] = bflo(a.w); g[7] = bfhi(a.w);
                u[0] = bflo(b.x); u[1] = bfhi(b.x); u[2] = bflo(b.y); u[3] = bfhi(b.y); u[4] = bflo(b.z); u[5] = bfhi(b.z); u[6] = bflo(b.w); u[7] = bfhi(b.w);
            }
        };
        ldrow(r0 - 1, pg, pu);
        ldrow(r0, cg_, cu);
#pragma unroll
        for (int rr = 0; rr < 8; ++rr) {
            const int row = r0 + rr;
            float ng[8], nu[8];
            ldrow(row + 1, ng, nu);
            float o[8];
#pragma unroll
            for (int e = 0; e < 8; ++e) {
                const float g = bg[e] + wg[0][e] * pg[e] + wg[1][e] * cg_[e] + wg[2][e] * ng[e];
                const float u = bu[e] + wu[0][e] * pu[e] + wu[1][e] * cu[e] + wu[2][e] * nu[e];
                const float sg = g * __builtin_amdgcn_rcpf(1.0f + __builtin_amdgcn_exp2f(-1.4426950408889634f * g));
                o[e] = sg * u;
            }
            const bool skip = (row == 0 && !first) || (row == 255 && !last);
            if (!skip) {
                u32x4 w; w.x = pk2(o[0], o[1]); w.y = pk2(o[2], o[3]); w.z = pk2(o[4], o[5]); w.w = pk2(o[6], o[7]);
                *(u32x4*)(act + (long)(R0 + row) * 2816 + jg) = w;
            }
#pragma unroll
            for (int e = 0; e < 8; ++e) { pg[e] = cg_[e]; pu[e] = cu[e]; cg_[e] = ng[e]; cu[e] = nu[e]; }
        }
        __syncthreads();
    }
};

template <class Epi>
DI void gemm_phase(const bf16_t* A, int lda, const bf16_t* Bt, int ldb, int N, int K, const Epi& epi, const float* ssq, char* lds, int tid) {
    asm volatile("" : "+v"(tid));
    const int wid = tid >> 6, lane = tid & 63, wr = wid >> 2, wc = wid & 3;
    const int nM = T / 256, nN = N / 256;
    for (int it = 0;; ++it) {
        int pm, pn;
        if (!tile_order(it * (int)gridDim.x + (int)blockIdx.x, nM, nN, pm, pn)) break;
        if (Epi::NEEDS_RSTD) __syncthreads();
        gacc_t acc;
        if (Epi::swap_tile(pn)) gemm_tile<Epi::NEEDS_RSTD, true>(acc, A + (long)pm * 256 * lda, lda, Bt + (long)pn * 256 * ldb, ldb, K, lds, tid, wr, wc, lane, ssq + (long)(pm * 256 + (tid & 255)) * 4);
        else gemm_tile<Epi::NEEDS_RSTD, false>(acc, A + (long)pm * 256 * lda, lda, Bt + (long)pn * 256 * ldb, ldb, K, lds, tid, wr, wc, lane, ssq + (long)(pm * 256 + (tid & 255)) * 4);
        epi(acc, pm, pn, lds, tid, wr, wc, lane);
    }
}

DI void convert_T(const float* __restrict__ W, int K, int N, bf16_t* __restrict__ Wt, bool permute, const float* __restrict__ gain, char* lds, int tid) {
    asm volatile("" : "+v"(tid));
    float* tile = (float*)lds;
    const int nnb = N / 64, ntiles = (K / 64) * nnb;
    for (int it = blockIdx.x; it < ntiles; it += gridDim.x) {
        const int k0 = (it / nnb) * 64, n0 = (it % nnb) * 64;
#pragma unroll
        for (int i = 0; i < 8; ++i) { const int idx = tid + NTH * i, kr = idx >> 6, nc = idx & 63; tile[kr * 65 + nc] = W[(long)(k0 + kr) * N + n0 + nc]; }
        __syncthreads();
#pragma unroll
        for (int i = 0; i < 8; ++i) {
            const int idx = tid + NTH * i, nr = idx >> 6, kc = idx & 63; const int n = n0 + nr; int nd = n;
            if (permute) { if (n < 2816) nd = (n >> 5) * 64 + (n & 31); else { const int j = n - 2816; nd = (j >> 5) * 64 + 32 + (j & 31); } }
            Wt[(long)nd * K + k0 + kc] = bf1(tile[kc * 65 + nr] * (gain ? gain[k0 + kc] : 1.0f));
        }
        __syncthreads();
    }
}

template <bool FINAL>
DI void norm_rows(const float* src0, const float* src1, const float* __restrict__ g, bf16_t* dst, float* fdst, float* copy, int wid, int lane) {
    asm volatile("" : "+v"(wid), "+v"(lane));
    for (int row = blockIdx.x * 8 + wid; row < T; row += gridDim.x * 8) {
        const float* xr = row < TP ? src0 + (long)row * 1024 : src1 + (long)(row - TP) * 1024;
        f32x4 v[4]; float ss = 0.f;
#pragma unroll
        for (int j = 0; j < 4; ++j) { v[j] = ((const f32x4*)xr)[lane + 64 * j]; ss += (v[j].x * v[j].x + v[j].y * v[j].y) + (v[j].z * v[j].z + v[j].w * v[j].w); }
        ss = wave_sum(ss);
        const float rstd = 1.0f / sqrtf(ss * (1.0f / 1024.0f) + 1e-6f);
#pragma unroll
        for (int j = 0; j < 4; ++j) {
            if (copy) ((f32x4*)(copy + (long)row * 1024))[lane + 64 * j] = v[j];
            const f32x4 gg = ((const f32x4*)g)[lane + 64 * j];
            const f32x4 o = v[j] * rstd * gg;
            if (FINAL) ((f32x4*)(fdst + (long)row * 1024))[lane + 64 * j] = o;
            else { u32x2 w; w.x = pk2(o.x, o.y); w.y = pk2(o.z, o.w); ((u32x2*)(dst + (long)row * 1024))[lane + 64 * j] = w; }
        }
    }
}

DI void final_norm(const bf16_t* __restrict__ xb, const float* __restrict__ g, float* __restrict__ out, int wid, int lane) {
    asm volatile("" : "+v"(wid), "+v"(lane));
    for (int row = blockIdx.x * 8 + wid; row < T; row += gridDim.x * 8) {
        const u32x4 a = *(const u32x4*)(xb + (long)row * 1024 + lane * 16), b = *(const u32x4*)(xb + (long)row * 1024 + lane * 16 + 8);
        float v[16];
#pragma unroll
        for (int e = 0; e < 4; ++e) { v[2 * e] = bflo(a[e]); v[2 * e + 1] = bfhi(a[e]); v[8 + 2 * e] = bflo(b[e]); v[8 + 2 * e + 1] = bfhi(b[e]); }
        float ss = 0.f;
#pragma unroll
        for (int e = 0; e < 16; ++e) ss += v[e] * v[e];
        ss = wave_sum(ss);
        const float rstd = 1.0f / sqrtf(ss * (1.0f / 1024.0f) + 1e-6f);
#pragma unroll
        for (int q = 0; q < 4; ++q) {
            const f32x4 gg = *(const f32x4*)(g + lane * 16 + q * 4);
            f32x4 o; o.x = v[4 * q] * rstd * gg.x; o.y = v[4 * q + 1] * rstd * gg.y; o.z = v[4 * q + 2] * rstd * gg.z; o.w = v[4 * q + 3] * rstd * gg.w;
            *(f32x4*)(out + (long)row * 1024 + lane * 16 + q * 4) = o;
        }
    }
}

DI void spatial_phase(const bf16_t* __restrict__ z, const bf16_t* __restrict__ wsb, const float* __restrict__ vgain, const float* __restrict__ bs,
                      bf16_t* __restrict__ y, char* lds, int tid, int wid, int lane) {
    float* srstd = (float*)(lds + 65536);
    char* la = lds; char* lb = lds + 32768;
    for (int unit = blockIdx.x; unit < T / 64; unit += gridDim.x) {
        asm volatile("" : "+v"(tid)); wid = tid >> 6; lane = tid & 63;
        const int l31 = lane & 31, hh = lane >> 5;
        const int wr = wid >> 1, wc = wid & 1;
        const long t0 = (long)(unit >> 1) * 128;
        const int g0 = (unit & 1) * 4;
#pragma unroll
        for (int rb = 0; rb < 4; ++rb) {
            u32x4 va[4], vb[4];
#pragma unroll
            for (int r = 0; r < 4; ++r) {
                const bf16_t* vr = z + (t0 + wid * 16 + rb * 4 + r) * 2048 + 1024 + lane * 16;
                va[r] = *(const u32x4*)vr; vb[r] = *(const u32x4*)(vr + 8);
            }
#pragma unroll
            for (int r = 0; r < 4; ++r) {
                float ss = 0.f;
#pragma unroll
                for (int e = 0; e < 4; ++e) { const float x0 = bflo(va[r][e]), x1 = bfhi(va[r][e]), x2 = bflo(vb[r][e]), x3 = bfhi(vb[r][e]); ss += (x0 * x0 + x1 * x1) + (x2 * x2 + x3 * x3); }
                ss = wave_sum(ss);
                if (lane == 0) srstd[wid * 16 + rb * 4 + r] = 1.0f / sqrtf(ss * (1.0f / 1024.0f) + 1e-6f);
            }
        }
        __syncthreads();
        for (int g = g0; g < g0 + 4; ++g) {
#pragma unroll
            for (int i = 0; i < 4; ++i) {
                const int id = tid + NTH * i, row = id >> 4, ch = id & 15;
                const u32x4 w = *(const u32x4*)(wsb + (long)(g * 128 + row) * 128 + ch * 8);
                *(u32x4*)(la + (ch >> 3) * 16384 + swz(row, ch & 7)) = w;
                const int q = row, d0 = ch * 8;
                const u32x4 vv = *(const u32x4*)(z + (t0 + q) * 2048 + 1024 + g * 128 + d0);
                const float rsq = srstd[q];
                const f32x4 g0 = *(const f32x4*)(vgain + g * 128 + d0), g1 = *(const f32x4*)(vgain + g * 128 + d0 + 4);
                float vals[8];
                vals[0] = bflo(vv.x) * rsq * g0.x; vals[1] = bfhi(vv.x) * rsq * g0.y; vals[2] = bflo(vv.y) * rsq * g0.z; vals[3] = bfhi(vv.y) * rsq * g0.w;
                vals[4] = bflo(vv.z) * rsq * g1.x; vals[5] = bfhi(vv.z) * rsq * g1.y; vals[6] = bflo(vv.w) * rsq * g1.z; vals[7] = bfhi(vv.w) * rsq * g1.w;
                char* dstb = lb + (q >> 6) * 16384 + (q & 7) * 2;
                const int qc = (q & 63) >> 3;
#pragma unroll
                for (int e = 0; e < 8; ++e) *(bf16_t*)(dstb + swz(d0 + e, qc)) = bf1(vals[e]);
            }
            __syncthreads();
            f32x16 acc[2];
#pragma unroll
            for (int n = 0; n < 2; ++n)
#pragma unroll
                for (int i = 0; i < 16; ++i) acc[n][i] = 0.f;
#pragma unroll
            for (int kh = 0; kh < 2; ++kh)
#pragma unroll
                for (int s = 0; s < 4; ++s) {
                    const bf16x8 af = ldfrag(la + kh * 16384, wr * 32 + l31, 2 * s + hh);
#pragma unroll
                    for (int n = 0; n < 2; ++n) { const bf16x8 bfr = ldfrag(lb + kh * 16384, wc * 64 + n * 32 + l31, 2 * s + hh); acc[n] = MFMA(af, bfr, acc[n]); }
                }
#pragma unroll
            for (int n = 0; n < 2; ++n)
#pragma unroll
                for (int i = 0; i < 16; ++i) {
                    const int p = wr * 32 + crow(i, hh), d = wc * 64 + n * 32 + l31;
                    const float val = acc[n][i] + bs[g * 128 + p];
                    const float uu = bflo((unsigned)z[(t0 + p) * 2048 + g * 128 + d]);
                    y[(t0 + p) * 1024 + g * 128 + d] = bf1(uu * val);
                }
            __syncthreads();
        }
    }
}

DI void attn_phase(const bf16_t* __restrict__ qb, const bf16_t* __restrict__ kb, const bf16_t* __restrict__ vt, bf16_t* __restrict__ ob,
                   const float* lq1, const float* lk1, const float* lq2, const float* lk2, const float* __restrict__ subg, float lam_init,
                   char* lds, int tid, int wid, int lane) {
    asm volatile("" : "+v"(tid)); wid = tid >> 6; lane = tid & 63;
    const int c = wid & 1, qs = wid >> 1, l31 = lane & 31, hh = lane >> 5;
    const float d1 = wave_sum(lq1[lane] * lk1[lane]), d2 = wave_sum(lq2[lane] * lk2[lane]);
    const float lam = expf(d1) - expf(d2) + lam_init;
    const int srow = tid >> 3, sch = tid & 7;
    const int wv = __builtin_amdgcn_readfirstlane(tid >> 6);
    LAS char* l3 = (LAS char*)lds;
    for (int u = blockIdx.x; u < 5120; u += gridDim.x) {
        int seq, head, qblk;
        if (u < 4096) { const int r = u >> 8, b = u & 255, x = b & 7, lb = b >> 3, p = (r >> 1) * 8 + x; seq = 4 + (p >> 3); head = p & 7; qblk = (r & 1) * 32 + lb; }
        else { const int v = u - 4096, r = v >> 8, b = v & 255, x = b & 7, lb = b >> 3, p = r * 8 + x; seq = p >> 3; head = p & 7; qblk = lb; }
        const int S = seq < 4 ? 4096 : 8192;
        const long t0 = seq < 4 ? (long)seq * 4096 : (long)TP + (long)(seq - 4) * 8192;
        const long qrow_t = t0 + qblk * 128 + qs * 32 + l31;
        bf16x8 qf[4];
        {
            const bf16_t* qrow = qb + qrow_t * 1024 + (head * 2 + c) * 64 + 8 * hh;
#pragma unroll
            for (int s = 0; s < 4; ++s) qf[s] = *(const bf16x8*)(qrow + 16 * s);
        }
        const int cl = sch ^ ((srow >> 1) & 7);
        const bf16_t* kp = kb + (t0 + srow) * 1024 + head * 128 + cl * 8;
        const bf16_t* vp = vt + t0 * 1024 + ((long)head * 128 + srow) * S + cl * 8;
        const int nkt = S / 64;
#define ATT_ISSUE(KT, ST) do { const int kt_ = (KT) < nkt ? (KT) : nkt - 1; LAS char* st_ = l3 + (ST) * 32768 + wv * 1024; \
            const bf16_t* kq_ = kp + (long)kt_ * 64 * 1024; const bf16_t* vq_ = vp + kt_ * 64; \
            __builtin_amdgcn_global_load_lds((const GAS unsigned*)kq_, (LAS unsigned*)st_, 16, 0, 0); \
            __builtin_amdgcn_global_load_lds((const GAS unsigned*)(kq_ + 64), (LAS unsigned*)(st_ + 8192), 16, 0, 0); \
            __builtin_amdgcn_global_load_lds((const GAS unsigned*)vq_, (LAS unsigned*)(st_ + 16384), 16, 0, 0); \
            __builtin_amdgcn_global_load_lds((const GAS unsigned*)(vq_ + (long)64 * S), (LAS unsigned*)(st_ + 24576), 16, 0, 0); } while (0)
        ATT_ISSUE(0, 0); ATT_ISSUE(1, 1); ATT_ISSUE(2, 2);
        f32x16 oacc[4];
#pragma unroll
        for (int ef = 0; ef < 4; ++ef)
#pragma unroll
            for (int i = 0; i < 16; ++i) oacc[ef][i] = 0.f;
        float l_run = 0.f;
        f32x16 negm;
#pragma unroll
        for (int i = 0; i < 16; ++i) negm[i] = 0.f;
        for (int kt = 0; kt < nkt; ++kt) {
            asm volatile("s_waitcnt vmcnt(8)" ::: "memory");
            asm volatile("s_waitcnt lgkmcnt(0)" ::: "memory"); __builtin_amdgcn_s_barrier();
            ATT_ISSUE(kt + 3, (kt + 3) & 3);
            const char* cur = lds + (kt & 3) * 32768;
            const char* kl = cur + c * 8192; const char* vl = cur + 16384;
            f32x16 sacc[2];
            {
                bf16x8 kfr[2][4];
#pragma unroll
                for (int kf = 0; kf < 2; ++kf)
#pragma unroll
                    for (int s = 0; s < 4; ++s) kfr[kf][s] = ldfrag(kl, kf * 32 + l31, 2 * s + hh);
#pragma unroll
                for (int kf = 0; kf < 2; ++kf) {
                    sacc[kf] = MFMA(kfr[kf][0], qf[0], negm);
#pragma unroll
                    for (int s = 1; s < 4; ++s) sacc[kf] = MFMA(kfr[kf][s], qf[s], sacc[kf]);
                }
            }
            bf16x8 vf[2][4];
#pragma unroll
            for (int ef = 0; ef < 4; ++ef) vf[0][ef] = ldfrag(vl, ef * 32 + l31, hh);
            __builtin_amdgcn_sched_group_barrier(0x100, 4, 0);
#pragma unroll
            for (int g_ = 0; g_ < 4; ++g_) { __builtin_amdgcn_sched_group_barrier(0x008, 1, 0); __builtin_amdgcn_sched_group_barrier(0x100, 1, 0); }
            __builtin_amdgcn_sched_group_barrier(0x008, 4, 0);
            __builtin_amdgcn_sched_group_barrier(0x100, 4, 0);
            float mx = fmaxf(fmaxf(sacc[0][0], sacc[0][1]), sacc[0][2]);
#pragma unroll
            for (int i = 3; i < 15; i += 2) mx = fmaxf(fmaxf(mx, sacc[0][i]), sacc[0][i + 1]);
            mx = fmaxf(fmaxf(mx, sacc[0][15]), sacc[1][0]);
#pragma unroll
            for (int i = 1; i < 15; i += 2) mx = fmaxf(fmaxf(mx, sacc[1][i]), sacc[1][i + 1]);
            mx = fmaxf(mx, sacc[1][15]);
            if (kt == 0 || __any(mx > 8.0f)) {
                const float mfull = fmaxf(mx, __shfl_xor(mx, 32));
                const float delta = kt == 0 ? mfull : fmaxf(mfull, 0.f);
                const float alpha = kt == 0 ? 1.0f : __builtin_amdgcn_exp2f(-delta);
                l_run *= alpha;
#pragma unroll
                for (int ef = 0; ef < 4; ++ef)
#pragma unroll
                    for (int i = 0; i < 16; ++i) oacc[ef][i] *= alpha;
#pragma unroll
                for (int i = 0; i < 16; ++i) { negm[i] -= delta; sacc[0][i] -= delta; sacc[1][i] -= delta; }
            }
            float ps = 0.f;
            bf16x8 pq[4];
#define ATT_SOFTQ(Q) do { const int kf_ = (Q) >> 1, s2_ = (Q) & 1; \
                _Pragma("unroll") for (int i = 0; i < 8; ++i) { const float p_ = __builtin_amdgcn_exp2f(sacc[kf_][8 * s2_ + i]); ps += p_; sacc[kf_][8 * s2_ + i] = p_; } \
                u32x4 w_; w_.x = pk2(sacc[kf_][8 * s2_ + 0], sacc[kf_][8 * s2_ + 1]); w_.y = pk2(sacc[kf_][8 * s2_ + 2], sacc[kf_][8 * s2_ + 3]); \
                w_.z = pk2(sacc[kf_][8 * s2_ + 4], sacc[kf_][8 * s2_ + 5]); w_.w = pk2(sacc[kf_][8 * s2_ + 6], sacc[kf_][8 * s2_ + 7]); \
                pq[Q] = __builtin_bit_cast(bf16x8, w_); } while (0)
            ATT_SOFTQ(0);
#pragma unroll
            for (int q = 0; q < 4; ++q) {
                if (q < 3) {
#pragma unroll
                    for (int ef = 0; ef < 4; ++ef) vf[(q + 1) & 1][ef] = ldfrag(vl, ef * 32 + l31, ((q + 1) >> 1) * 4 + 2 * ((q + 1) & 1) + hh);
                    if (q == 0) ATT_SOFTQ(1); else if (q == 1) ATT_SOFTQ(2); else ATT_SOFTQ(3);
                }
#pragma unroll
                for (int ef = 0; ef < 4; ++ef) oacc[ef] = MFMA(vf[q & 1][ef], pq[q], oacc[ef]);
            }
            l_run += ps;
            __builtin_amdgcn_sched_group_barrier(0x002, 20, 0);
#pragma unroll
            for (int g_ = 0; g_ < 12; ++g_) { __builtin_amdgcn_sched_group_barrier(0x008, 1, 0); __builtin_amdgcn_sched_group_barrier(0x100, 1, 0); __builtin_amdgcn_sched_group_barrier(0x002, 5, 0); }
            __builtin_amdgcn_sched_group_barrier(0x008, 4, 0);
        }
        asm volatile("s_waitcnt vmcnt(0)" ::: "memory");
        __syncthreads();
        const float lt = l_run + __shfl_xor(l_run, 32);
        const float inv = 1.0f / lt;
        float* xch = (float*)lds;
        if (c == 1) {
#pragma unroll
            for (int ef = 0; ef < 4; ++ef)
#pragma unroll
                for (int i = 0; i < 16; ++i) xch[((qs * 4 + ef) * 16 + i) * 64 + lane] = oacc[ef][i] * inv;
        }
        __syncthreads();
        if (c == 0) {
            float ss = 0.f;
#pragma unroll
            for (int ef = 0; ef < 4; ++ef)
#pragma unroll
                for (int i = 0; i < 16; ++i) { const float o = oacc[ef][i] * inv - lam * xch[((qs * 4 + ef) * 16 + i) * 64 + lane]; oacc[ef][i] = o; ss += o * o; }
            ss += __shfl_xor(ss, 32);
            const float rstd = (1.0f - lam_init) / sqrtf(ss * (1.0f / 128.0f) + 1e-5f);
            bf16_t* orow = ob + qrow_t * 1024 + head * 128;
#pragma unroll
            for (int ef = 0; ef < 4; ++ef)
#pragma unroll
                for (int g4 = 0; g4 < 4; ++g4) {
                    const int e = ef * 32 + 8 * g4 + 4 * hh;
                    const f32x4 gv = *(const f32x4*)(subg + e);
                    u32x2 w;
                    w.x = pk2(oacc[ef][4 * g4 + 0] * rstd * gv.x, oacc[ef][4 * g4 + 1] * rstd * gv.y);
                    w.y = pk2(oacc[ef][4 * g4 + 2] * rstd * gv.z, oacc[ef][4 * g4 + 3] * rstd * gv.w);
                    *(u32x2*)(orow + e) = w;
                }
        }
        __syncthreads();
    }
}

DI void unpack8(const u32x4 a, float (&f)[8]) {
    f[0] = bflo(a.x); f[1] = bfhi(a.x); f[2] = bflo(a.y); f[3] = bfhi(a.y); f[4] = bflo(a.z); f[5] = bfhi(a.z); f[6] = bflo(a.w); f[7] = bfhi(a.w);
}
DI void ffn_fixup(const bf16_t* halo, const float* cw, const float* cb, bf16_t* act, int tid) {
    asm volatile("" : "+v"(tid));
    const int total = 319 * 2 * 352;
    for (int idx = blockIdx.x * NTH + tid; idx < total; idx += gridDim.x * NTH) {
        const int b = idx / 704, rem = idx - b * 704, which = rem >= 352 ? 1 : 0, jc = rem - which * 352;
        const int R0 = (b + 1) * 256;
        if (is_seq_start(R0)) continue;
        const int j0 = jc * 8;
        const int ng = (j0 >> 5) * 64 + (j0 & 31);
        const bf16_t* hp = halo + (long)(b * 4 + 2 + which) * 5632 + ng;
        float g[3][8], u[3][8];
#pragma unroll
        for (int t = 0; t < 3; ++t) {
            unpack8(*(const u32x4*)(hp + (long)t * 5632), g[t]);
            unpack8(*(const u32x4*)(hp + (long)t * 5632 + 32), u[t]);
        }
        float o[8];
#pragma unroll
        for (int e = 0; e < 8; ++e) {
            const int j = j0 + e;
            const float gg = cb[j] + cw[j] * g[0][e] + cw[5632 + j] * g[1][e] + cw[2 * 5632 + j] * g[2][e];
            const float uu = cb[2816 + j] + cw[2816 + j] * u[0][e] + cw[5632 + 2816 + j] * u[1][e] + cw[2 * 5632 + 2816 + j] * u[2][e];
            o[e] = gg * __builtin_amdgcn_rcpf(1.0f + __builtin_amdgcn_exp2f(-1.4426950408889634f * gg)) * uu;
        }
        u32x4 w; w.x = pk2(o[0], o[1]); w.y = pk2(o[2], o[3]); w.z = pk2(o[4], o[5]); w.w = pk2(o[6], o[7]);
        *(u32x4*)(act + (long)(R0 - 1 + which) * 2816 + j0) = w;
    }
}

DI float dot8(const u32x4 a, const u32x4 b) {
    float s = 0.f;
#pragma unroll
    for (int e = 0; e < 4; ++e) s += bflo(a[e]) * bflo(b[e]) + bfhi(a[e]) * bfhi(b[e]);
    return s;
}
DI void ffn_fixup2(const bf16_t* __restrict__ hb, const bf16_t* __restrict__ wfin, const float* __restrict__ cw, const float* __restrict__ cb, bf16_t* __restrict__ act, int tid) {
    asm volatile("" : "+v"(tid));
    const int total = 319 * 2 * 2816;
    for (int idx = blockIdx.x * NTH + tid; idx < total; idx += gridDim.x * NTH) {
        const int b = idx / 5632, rem = idx % 5632, which = rem / 2816, j = rem % 2816;
        const int R0 = (b + 1) * 256;
        if (is_seq_start(R0)) continue;
        const int ng = (j >> 5) * 64 + (j & 31), nu = ng + 32;
        const int r = R0 - 1 + which;
        const bf16_t* h0 = hb + (long)(r - 1) * 1024; const bf16_t* h1 = h0 + 1024; const bf16_t* h2 = h1 + 1024;
        const bf16_t* wgp = wfin + (long)ng * 1024; const bf16_t* wup = wfin + (long)nu * 1024;
        float ag0 = 0.f, ag1 = 0.f, ag2 = 0.f, au0 = 0.f, au1 = 0.f, au2 = 0.f;
        for (int k = 0; k < 1024; k += 8) {
            const u32x4 x0 = *(const u32x4*)(h0 + k), x1 = *(const u32x4*)(h1 + k), x2 = *(const u32x4*)(h2 + k);
            const u32x4 g8 = *(const u32x4*)(wgp + k), u8 = *(const u32x4*)(wup + k);
            ag0 += dot8(x0, g8); ag1 += dot8(x1, g8); ag2 += dot8(x2, g8);
            au0 += dot8(x0, u8); au1 += dot8(x1, u8); au2 += dot8(x2, u8);
        }
        const float g = cb[j] + cw[j] * ag0 + cw[5632 + j] * ag1 + cw[2 * 5632 + j] * ag2;
        const float u = cb[2816 + j] + cw[2816 + j] * au0 + cw[5632 + 2816 + j] * au1 + cw[2 * 5632 + 2816 + j] * au2;
        const float sg = g * __builtin_amdgcn_rcpf(1.0f + __builtin_amdgcn_exp2f(-1.4426950408889634f * g));
        act[(long)r * 2816 + j] = bf1(sg * u);
    }
}


#define XB_TMO      128
#define XB_XCNT(j)  (256  + 64 * (j))
#define XB_XSUB(j)  (1280 + 64 * (j))
#define XB_XGEN(j)  (2304 + 64 * (j))
#define XB_TOP      3328
#define XB_TOPGEN   3392
#define XCD_BAR_WORDS 3456
#define XB_SPIN_CAP (1u << 18)
DI unsigned xb_ld(unsigned* p)              { return __hip_atomic_load(p, __ATOMIC_RELAXED, __HIP_MEMORY_SCOPE_AGENT); }
DI unsigned xb_add(unsigned* p, unsigned v) { return __hip_atomic_fetch_add(p, v, __ATOMIC_RELAXED, __HIP_MEMORY_SCOPE_AGENT); }
DI unsigned xb_xcc_id() { return (unsigned)__builtin_amdgcn_s_getreg((3 << 11) | 20) & 0xFu; }
#define XB_SPIN(cond, bar) do { unsigned _sp = 0; while (cond) { __builtin_amdgcn_s_sleep(1); \
    if ((++_sp & 255u) == 0u) { if (xb_ld(&(bar)[XB_TMO])) break; if (_sp > XB_SPIN_CAP) { atomicAdd(&(bar)[XB_TMO], 1u); break; } } } } while (0)
struct XcdBarrier { unsigned* bar; unsigned x; volatile LAS unsigned* st; };
DI XcdBarrier xcd_barrier_post(unsigned* bar, volatile LAS unsigned* st) {
    XcdBarrier b; b.bar = bar; b.x = xb_xcc_id(); b.st = st;
    if (threadIdx.x == 0) (void)xb_add(&bar[XB_XCNT(b.x)], 1u);
    return b;
}
DI void xcd_barrier_complete(unsigned* bar, unsigned x, unsigned& nloc, unsigned& nx) {
    const unsigned G = gridDim.x * gridDim.y * gridDim.z;
    unsigned sum, cnt, mine, sp = 0u;
    for (;;) {
        sum = 0u; cnt = 0u; mine = 0u;
#pragma unroll
        for (unsigned j = 0; j < 16; ++j) { const unsigned c = xb_ld(&bar[XB_XCNT(j)]); sum += c; cnt += (c > 0u) ? 1u : 0u; mine = (j == x) ? c : mine; }
        if (sum == G) break;
        __builtin_amdgcn_s_sleep(1);
        if ((++sp & 255u) == 0u) { if (xb_ld(&bar[XB_TMO])) break; if (sp > XB_SPIN_CAP) { atomicAdd(&bar[XB_TMO], 1u); break; } }
    }
    nloc = mine > 0u ? mine : 1u; nx = cnt > 0u ? cnt : 1u;
}
DI void xcd_barrier(const XcdBarrier& b) {
    asm volatile("s_waitcnt vmcnt(0)" ::: "memory");
    __syncthreads();
    if (threadIdx.x == 0) {
        unsigned* bar = b.bar;
        __builtin_amdgcn_s_waitcnt(0);
        unsigned nloc = b.st[0], nx = b.st[1];
        if (nloc == 0u) { xcd_barrier_complete(bar, b.x, nloc, nx); b.st[0] = nloc; b.st[1] = nx; }
        const unsigned old = xb_add(&bar[XB_XSUB(b.x)], 1u);
        const unsigned gen = old / nloc;
        if (old + 1u == (gen + 1u) * nloc) {
            __builtin_amdgcn_fence(__ATOMIC_RELEASE, "agent");
            asm volatile("s_waitcnt vmcnt(0)" ::: "memory");
            const unsigned og = xb_add(&bar[XB_TOP], 1u);
            const unsigned tg = og / nx;
            if (og + 1u == (tg + 1u) * nx) xb_add(&bar[XB_TOPGEN], 1u);
            else XB_SPIN(xb_ld(&bar[XB_TOPGEN]) == tg, bar);
            __builtin_amdgcn_fence(__ATOMIC_ACQUIRE, "agent");
            xb_add(&bar[XB_XGEN(b.x)], 1u);
            asm volatile("s_waitcnt vmcnt(0)" ::: "memory");
        } else {
            XB_SPIN(xb_ld(&bar[XB_XGEN(b.x)]) == gen, bar);
            __builtin_amdgcn_fence(__ATOMIC_ACQUIRE, "agent");
            asm volatile("s_waitcnt vmcnt(0)" ::: "memory");
        }
    }
    __syncthreads();
}
#define GSYNC_CG() do { asm volatile("s_waitcnt vmcnt(0)" ::: "memory"); grid.sync(); } while (0)
#define GSYNC() do { XcdBarrier xb_; xb_.bar = (unsigned*)(p.ws + OFF_BAR); xb_.x = xb_xcc_id(); xb_.st = (volatile LAS unsigned*)((LAS char*)lds + XB_LDS_OFF); xcd_barrier(xb_); } while (0)
__global__ void __launch_bounds__(512) mega(Params p) {
    extern __shared__ __attribute__((aligned(16))) char lds[];
    cg::grid_group grid = cg::this_grid();
    const int tid = threadIdx.x, wid = tid >> 6, lane = tid & 63;
    char* ws = p.ws;
    if (tid < 4) ((volatile LAS unsigned*)((LAS char*)lds + XB_LDS_OFF))[tid] = 0u;
    __syncthreads();
    (void)xcd_barrier_post((unsigned*)(ws + OFF_BAR), (volatile LAS unsigned*)((LAS char*)lds + XB_LDS_OFF));
    bf16_t* w_gin = (bf16_t*)(ws + OFF_GIN); bf16_t* w_gout = (bf16_t*)(ws + OFF_GOUT); bf16_t* w_gs = (bf16_t*)(ws + OFF_GS);
    bf16_t* w_qkv = (bf16_t*)(ws + OFF_QKV); bf16_t* w_dout = (bf16_t*)(ws + OFF_DOUT); bf16_t* w_fin = (bf16_t*)(ws + OFF_FIN); bf16_t* w_fout = (bf16_t*)(ws + OFF_FOUT);
    f32x2* rope = (f32x2*)(ws + OFF_ROPE);
    bf16_t* hb = (bf16_t*)(ws + OFF_H); bf16_t* big = (bf16_t*)(ws + OFF_BIG); bf16_t* halo = (bf16_t*)(ws + OFF_HALO);
    bf16_t* yo = (bf16_t*)p.out;

    bf16_t* hb2 = (bf16_t*)(ws + OFF_H2); float* ssq = (float*)(ws + OFF_SSQ);
    for (int j = 0; j < 2; ++j) {
        convert_T(p.in[5] + (long)j * 1024 * 2048, 1024, 2048, w_gin + (long)j * 2048 * 1024, false, p.in[2] + (2 * j) * 1024, lds, tid);
        convert_T(p.in[9] + (long)j * 1024 * 1024, 1024, 1024, w_gout + (long)j * 1024 * 1024, false, nullptr, lds, tid);
        convert_T(p.in[10] + (long)j * 1024 * 3072, 1024, 3072, w_qkv + (long)j * 3072 * 1024, false, p.in[2] + (2 * j + 1) * 1024, lds, tid);
        convert_T(p.in[16] + (long)j * 1024 * 1024, 1024, 1024, w_dout + (long)j * 1024 * 1024, false, nullptr, lds, tid);
    }
    for (int j = 0; j < 4; ++j) {
        convert_T(p.in[17] + (long)j * 1024 * 5632, 1024, 5632, w_fin + (long)j * 5632 * 1024, true, p.in[3] + j * 1024, lds, tid);
        convert_T(p.in[20] + (long)j * 2816 * 1024, 2816, 1024, w_fout + (long)j * 1024 * 2816, false, nullptr, lds, tid);
    }
    for (int idx = blockIdx.x * NTH + tid; idx < 2 * 8 * 128 * 128; idx += gridDim.x * NTH) w_gs[idx] = bf1(p.in[7][idx]);
    for (int idx = blockIdx.x * NTH + tid; idx < 8192 * 32; idx += gridDim.x * NTH) {
        const int pos = idx >> 5, i = idx & 31;
        const float ang = (float)pos * p.inv_freq[i];
        const double a = (double)ang;
        const double n = rint(a * 0.15915494309189535);
        double r = fma(-n, 6.283185307179586, a);
        r = fma(-n, 2.4492935982947064e-16, r);
        const float rf = (float)r;
        f32x2 cs; cs.x = cosf(rf); cs.y = sinf(rf);
        rope[idx] = cs;
    }
    for (int row = blockIdx.x * 8 + wid; row < T; row += gridDim.x * 8) {
        const float* xr = row < TP ? p.in[0] + (long)row * 1024 : p.in[1] + (long)(row - TP) * 1024;
        float ss = 0.f;
#pragma unroll
        for (int jj = 0; jj < 4; ++jj) {
            const f32x4 v = ((const f32x4*)xr)[lane + 64 * jj];
            u32x2 w; w.x = pk2(v.x, v.y); w.y = pk2(v.z, v.w);
            ((u32x2*)(hb + (long)row * 1024))[lane + 64 * jj] = w;
            const float a0 = bflo(w.x), a1 = bfhi(w.x), a2 = bflo(w.y), a3 = bfhi(w.y);
            ss += (a0 * a0 + a1 * a1) + (a2 * a2 + a3 * a3);
        }
        ss = wave_sum(ss);
        if (lane == 0) { f32x4 q = {ss, 0.f, 0.f, 0.f}; *(f32x4*)(ssq + (long)row * 4) = q; }
    }
    GSYNC_CG();

    for (int layer = 0; layer < 4; ++layer) {
        const int j = layer >> 1;
        char* wsl = p.ws; asm volatile("" : "+s"(wsl));
        bf16_t* w_gin = (bf16_t*)(wsl + OFF_GIN); bf16_t* w_gout = (bf16_t*)(wsl + OFF_GOUT); bf16_t* w_gs = (bf16_t*)(wsl + OFF_GS);
        bf16_t* w_qkv = (bf16_t*)(wsl + OFF_QKV); bf16_t* w_dout = (bf16_t*)(wsl + OFF_DOUT); bf16_t* w_fin = (bf16_t*)(wsl + OFF_FIN); bf16_t* w_fout = (bf16_t*)(wsl + OFF_FOUT);
        f32x2* rope = (f32x2*)(wsl + OFF_ROPE);
        bf16_t* hb = (bf16_t*)(wsl + OFF_H); bf16_t* big = (bf16_t*)(wsl + OFF_BIG); bf16_t* halo = (bf16_t*)(wsl + OFF_HALO);
        bf16_t* hb2 = (bf16_t*)(wsl + OFF_H2); float* ssq = (float*)(wsl + OFF_SSQ);
        bf16_t* yo = (bf16_t*)p.out; asm volatile("" : "+s"(yo));
        if ((layer & 1) == 0) {
            { EpiGelu e{big}; gemm_phase(hb, 1024, w_gin + (long)j * 2048 * 1024, 1024, 2048, 1024, e, ssq, lds, tid); }
            GSYNC();
            spatial_phase(big, w_gs + (long)j * 8 * 128 * 128, p.in[6] + j * 1024, p.in[8] + j * 1024, yo, lds, tid, wid, lane);
            GSYNC();
            { EpiResid e{hb, hb2, ssq}; gemm_phase(yo, 1024, w_gout + (long)j * 1024 * 1024, 1024, 1024, 1024, e, ssq, lds, tid); }
            GSYNC();
        } else {
            bf16_t* qb = big; bf16_t* kb = big + (long)T * 1024; bf16_t* vt = big + (long)T * 2048;
            { EpiQkv e{qb, kb, vt, rope}; gemm_phase(hb, 1024, w_qkv + (long)j * 3072 * 1024, 1024, 3072, 1024, e, ssq, lds, tid); }
            GSYNC();
            const float lam_init = 0.8f - 0.6f * expf(-0.3f * (float)layer);
            attn_phase(qb, kb, vt, yo, p.in[11] + j * 64, p.in[12] + j * 64, p.in[13] + j * 64, p.in[14] + j * 64, p.in[15] + j * 128, lam_init, lds, tid, wid, lane);
            GSYNC();
            { EpiResid e{hb, hb2, ssq}; gemm_phase(yo, 1024, w_dout + (long)j * 1024 * 1024, 1024, 1024, 1024, e, ssq, lds, tid); }
            GSYNC();
        }
        { EpiFfn e{p.in[18] + (long)layer * 3 * 5632, p.in[19] + (long)layer * 5632, big, halo};
          gemm_phase(hb2, 1024, w_fin + (long)layer * 5632 * 1024, 1024, 5632, 1024, e, ssq, lds, tid); }
        GSYNC();
        ffn_fixup(halo, p.in[18] + (long)layer * 3 * 5632, p.in[19] + (long)layer * 5632, big, tid);
        GSYNC();
        { EpiResid e{hb2, hb, ssq}; gemm_phase(big, 2816, w_fout + (long)layer * 1024 * 2816, 2816, 1024, 2816, e, ssq, lds, tid); }
        GSYNC();
    }
    {
        int t_end = threadIdx.x; asm volatile("" : "+v"(t_end));
        char* wse = p.ws; asm volatile("" : "+s"(wse));
        final_norm((const bf16_t*)(wse + OFF_H), p.in[4], p.out, t_end >> 6, t_end & 63);
    }
}

extern "C" void kernel_launch(void* const* d_in, const int* in_sizes, int n_in, void* d_out, int out_size, void* d_ws, size_t ws_size,
                              hipStream_t stream) {
    static int grid_blocks = 0;
    if (grid_blocks == 0) {
        if (n_in != 21 || out_size != T * D || ws_size < WS_END) { fprintf(stderr, "kernel_launch: unexpected sizes n_in %d out %d ws %zu (need %zu)\n", n_in, out_size, ws_size, (size_t)WS_END); grid_blocks = -1; return; }
        int dev = 0, cus = 0, per_cu = 0;
        hipGetDevice(&dev);
        hipDeviceGetAttribute(&cus, hipDeviceAttributeMultiprocessorCount, dev);
        hipFuncSetAttribute((const void*)mega, hipFuncAttributeMaxDynamicSharedMemorySize, LDS_BYTES);
        hipOccupancyMaxActiveBlocksPerMultiprocessor(&per_cu, (const void*)mega, NTH, LDS_BYTES);
        if (per_cu < 1) { fprintf(stderr, "kernel_launch: occupancy query says %d blocks/CU\n", per_cu); per_cu = 1; }
        grid_blocks = cus * per_cu;
        (void)hipGetLastError();
    }
    if (grid_blocks < 0) return;
    Params p{};
    for (int i = 0; i < 21; ++i) p.in[i] = (const float*)d_in[i];
    p.out = (float*)d_out; p.ws = (char*)d_ws;
    for (int i = 0; i < 32; ++i) p.inv_freq[i] = (float)pow(10000.0, -(double)i / 32.0);
    (void)hipMemsetAsync((char*)d_ws + OFF_BAR, 0, 3456 * 4, stream);
    void* args[] = {&p};
    hipError_t e = hipLaunchCooperativeKernel((const void*)mega, dim3(grid_blocks), dim3(NTH), args, LDS_BYTES, stream);
    if (e != hipSuccess) fprintf(stderr, "cooperative launch failed: %s (grid %d)\n", hipGetErrorString(e), grid_blocks);
}
```

```cpp
#include <hip/hip_runtime.h>
#include <hip/hip_cooperative_groups.h>
#include <cmath>
#include <cstdio>
namespace cg = cooperative_groups;

typedef unsigned short bf16_t;
typedef short bf16x8 __attribute__((ext_vector_type(8)));
typedef float f32x16 __attribute__((ext_vector_type(16)));
typedef float f32x4 __attribute__((ext_vector_type(4)));
typedef float f32x2 __attribute__((ext_vector_type(2)));
typedef unsigned u32x4 __attribute__((ext_vector_type(4)));
typedef unsigned u32x2 __attribute__((ext_vector_type(2)));
typedef __bf16 bf16x2_t __attribute__((ext_vector_type(2)));

#define DI __device__ __forceinline__
#define MFMA(a, b, c) __builtin_amdgcn_mfma_f32_32x32x16_bf16((a), (b), (c), 0, 0, 0)
#define MFMA16(a, b, c) __builtin_amdgcn_mfma_f32_16x16x32_bf16((a), (b), (c), 0, 0, 0)
typedef f32x4 gacc_t[8][4];

constexpr int T = 81920, TP = 16384, D = 1024, NTH = 512;
constexpr int XB_LDS_OFF = 256 * 528 + 1024;
constexpr int LDS_BYTES = 256 * 528 + 1024 + 16;

constexpr size_t OFF_GIN = 0;
constexpr size_t OFF_GOUT = OFF_GIN + 2ull * 2048 * 1024 * 2;
constexpr size_t OFF_GS = OFF_GOUT + 2ull * 1024 * 1024 * 2;
constexpr size_t OFF_QKV = OFF_GS + 2ull * 8 * 128 * 128 * 2;
constexpr size_t OFF_DOUT = OFF_QKV + 2ull * 3072 * 1024 * 2;
constexpr size_t OFF_FIN = OFF_DOUT + 2ull * 1024 * 1024 * 2;
constexpr size_t OFF_FOUT = OFF_FIN + 4ull * 5632 * 1024 * 2;
constexpr size_t OFF_ROPE = OFF_FOUT + 4ull * 1024 * 2816 * 2;
constexpr size_t OFF_H = OFF_ROPE + 8192ull * 32 * 8;
constexpr size_t OFF_BIG = OFF_H + (size_t)T * 1024 * 2;
constexpr size_t OFF_HALO = OFF_BIG + (size_t)T * 3072 * 2;
constexpr size_t OFF_H2 = OFF_HALO + 320ull * 4 * 5632 * 2;
constexpr size_t OFF_SSQ = OFF_H2 + (size_t)T * 1024 * 2;
constexpr size_t OFF_BAR = OFF_SSQ + (size_t)T * 4 * 4;
constexpr size_t WS_END = OFF_BAR + 3456 * 4;
constexpr int RSTD_OFF = 256 * 528;

struct Params {
    const float* in[21];
    float* out;
    char* ws;
    float inv_freq[32];
};

DI unsigned pk2(float a, float b) { f32x2 v = {a, b}; bf16x2_t r = __builtin_convertvector(v, bf16x2_t); return __builtin_bit_cast(unsigned, r); }
DI bf16_t bf1(float a) { return (bf16_t)(pk2(a, 0.f) & 0xffffu); }
DI float bflo(unsigned w) { return __uint_as_float(w << 16); }
DI float bfhi(unsigned w) { return __uint_as_float(w & 0xffff0000u); }
DI float wave_sum(float v) {
#pragma unroll
    for (int o = 1; o < 64; o <<= 1) v += __shfl_xor(v, o);
    return v;
}
DI int crow(int i, int h) { return (i & 3) + 8 * (i >> 2) + 4 * h; }
DI int swz(int row, int chunk) { return row * 128 + ((chunk ^ ((row >> 1) & 7)) << 4); }
DI bf16x8 ldfrag(const char* lds, int row, int chunk) { return *(const bf16x8*)(lds + swz(row, chunk)); }
DI bool is_seq_start(int R) { return R < TP ? (R & 4095) == 0 : ((R - TP) & 8191) == 0; }

#define GAS __attribute__((address_space(1)))
#define LAS __attribute__((address_space(3)))
template <bool RSTD, bool SWAP>
DI void gemm_tile(gacc_t& acc, const bf16_t* __restrict__ A, int lda, const bf16_t* __restrict__ Bt, int ldb, int K,
                  char* lds, int tid, int wr, int wc, int lane, const float* ssq_row) {
#pragma unroll
    for (int m = 0; m < 8; ++m)
#pragma unroll
        for (int n = 0; n < 4; ++n)
#pragma unroll
            for (int j = 0; j < 4; ++j) acc[m][n][j] = 0.f;
    const int nk = K / 64;
    const int fr = lane & 15, fq = lane >> 4;
    const int srow = tid >> 3, sch = tid & 7;
    const int cl = sch ^ ((srow >> 1) & 7);
    const int wv = __builtin_amdgcn_readfirstlane(tid >> 6);
    const bf16_t* ap = A + (long)srow * lda + cl * 8;
    const bf16_t* bp = Bt + (long)srow * ldb + cl * 8;
    LAS char* l3 = (LAS char*)lds;
#define GEMM_ISSUE(KT, ST) do { \
        _Pragma("unroll") for (int i_ = 0; i_ < 4; ++i_) { \
            __builtin_amdgcn_global_load_lds((const GAS unsigned*)(ap + (long)(64 * i_) * lda + (KT) * 64), (LAS unsigned*)(l3 + (ST) * 65536 + i_ * 8192 + wv * 1024), 16, 0, 0); \
            __builtin_amdgcn_global_load_lds((const GAS unsigned*)(bp + (long)(64 * i_) * ldb + (KT) * 64), (LAS unsigned*)(l3 + (ST) * 65536 + 32768 + i_ * 8192 + wv * 1024), 16, 0, 0); \
        } } while (0)
    GEMM_ISSUE(0, 0);
    if (RSTD && tid < 256) {
        const f32x4 q = *(const f32x4*)ssq_row;
        ((float*)(lds + RSTD_OFF))[tid] = 1.0f / sqrtf(((q.x + q.y) + (q.z + q.w)) * (1.0f / 1024.0f) + 1e-6f);
    }
    asm volatile("s_waitcnt vmcnt(0)" ::: "memory");
    __syncthreads();
    for (int kt = 0; kt < nk; ++kt) {
        const char* cur = lds + (kt & 1) * 65536;
        if (kt + 1 < nk) GEMM_ISSUE(kt + 1, (kt + 1) & 1);
        bf16x8 bfr[2][4], afr[3];
#pragma unroll
        for (int n = 0; n < 4; ++n) bfr[0][n] = ldfrag(cur + 32768, wc * 64 + n * 16 + fr, fq);
        afr[0] = ldfrag(cur, wr * 128 + fr, fq);
        afr[1] = ldfrag(cur, wr * 128 + 16 + fr, fq);
#pragma unroll
        for (int idx = 0; idx < 16; ++idx) {
            const int ks = idx >> 3, m = idx & 7;
            if (idx < 14) afr[(idx + 2) % 3] = ldfrag(cur, wr * 128 + ((idx + 2) & 7) * 16 + fr, ((idx + 2) >> 3) * 4 + fq);
            if (ks == 0 && m >= 2 && m < 6) bfr[1][m - 2] = ldfrag(cur + 32768, wc * 64 + (m - 2) * 16 + fr, 4 + fq);
#pragma unroll
            for (int n = 0; n < 4; ++n) acc[m][n] = SWAP ? MFMA16(bfr[ks][n], afr[idx % 3], acc[m][n]) : MFMA16(afr[idx % 3], bfr[ks][n], acc[m][n]);
        }
        __builtin_amdgcn_sched_group_barrier(0x100, 6, 0);
#define GEMM_SG1() do { __builtin_amdgcn_sched_group_barrier(0x100, 1, 0); __builtin_amdgcn_sched_group_barrier(0x008, 4, 0); } while (0)
#define GEMM_SG2() do { __builtin_amdgcn_sched_group_barrier(0x100, 2, 0); __builtin_amdgcn_sched_group_barrier(0x008, 4, 0); } while (0)
        GEMM_SG1(); GEMM_SG1(); GEMM_SG2(); GEMM_SG2(); GEMM_SG2(); GEMM_SG2(); GEMM_SG1(); GEMM_SG1();
        GEMM_SG1(); GEMM_SG1(); GEMM_SG1(); GEMM_SG1(); GEMM_SG1(); GEMM_SG1();
        __builtin_amdgcn_sched_group_barrier(0x008, 8, 0);
        __builtin_amdgcn_sched_barrier(0);
        asm volatile("s_waitcnt vmcnt(0)" ::: "memory");
        __syncthreads();
    }
}

DI bool tile_order(int L, int nM, int nN, int& pm, int& pn) {
    const int nwg = nM * nN;
    if (L >= nwg) return false;
    int wgid = L;
    { const int q = nwg / 8, r = nwg % 8, xcd = wgid % 8, off = wgid / 8; wgid = (xcd < r ? xcd * (q + 1) : r * (q + 1) + (xcd - r) * q) + off; }
    const int nig = 8 * nN, gid = wgid / nig, fm = gid * 8, gsz = (nM - fm) < 8 ? (nM - fm) : 8;
    pm = fm + ((wgid % nig) % gsz); pn = (wgid % nig) / gsz;
    return true;
}

DI void store_tile_from_lds(const char* lds, bf16_t* dst, long ld, int tid) {
#pragma unroll
    for (int k = 0; k < 16; ++k) {
        const int id = tid + NTH * k, row = id >> 5, ch = id & 31;
        const u32x4 v = *(const u32x4*)(lds + row * 528 + ch * 16);
        *(u32x4*)(dst + (long)row * ld + ch * 8) = v;
    }
}
struct EpiGelu {
    static constexpr bool NEEDS_RSTD = true;
    static DI bool swap_tile(int) { return true; }
    bf16_t* z;
    DI void operator()(gacc_t& acc, int pm, int pn, char* lds, int tid, int wr, int wc, int lane) const {
        asm volatile("" : "+v"(tid), "+v"(lane));
        const int fr = lane & 15, fq = lane >> 4;
        char* lbase = lds + (wr * 128 + fr) * 528 + (wc * 64 + 4 * fq) * 2;
        const float* rl = (const float*)(lds + RSTD_OFF) + wr * 128 + fr;
#pragma unroll
        for (int m = 0; m < 8; ++m) {
            const float r = rl[m * 16];
#pragma unroll
            for (int n = 0; n < 4; ++n) {
                float g[4];
#pragma unroll
                for (int j = 0; j < 4; ++j) {
                    const float x = acc[m][n][j] * r;
                    const float u = 0.7978845608028654f * (x + 0.044715f * x * x * x);
                    const float e = __builtin_amdgcn_exp2f(-2.885390081777927f * u);
                    g[j] = x * __builtin_amdgcn_rcpf(1.0f + e);
                }
                u32x2 w; w.x = pk2(g[0], g[1]); w.y = pk2(g[2], g[3]);
                *(u32x2*)(lbase + m * 16 * 528 + n * 32) = w;
            }
            __builtin_amdgcn_sched_barrier(0);
        }
        __syncthreads();
        store_tile_from_lds(lds, z + (long)pm * 256 * 2048 + pn * 256, 2048, tid);
        __syncthreads();
    }
};
struct EpiResid {
    static constexpr bool NEEDS_RSTD = false;
    static DI bool swap_tile(int) { return true; }
    const bf16_t* xold; bf16_t* xnew; float* ssq;
    DI void operator()(gacc_t& acc, int pm, int pn, char* lds, int tid, int wr, int wc, int lane) const {
        asm volatile("" : "+v"(tid), "+v"(lane));
        const int fr = lane & 15, fq = lane >> 4, wid = tid >> 6;
        char* lbase = lds + (wr * 128 + fr) * 528 + (wc * 64 + 4 * fq) * 2;
#pragma unroll
        for (int m = 0; m < 8; ++m)
#pragma unroll
            for (int n = 0; n < 4; ++n) { u32x2 w; w.x = pk2(acc[m][n][0], acc[m][n][1]); w.y = pk2(acc[m][n][2], acc[m][n][3]); *(u32x2*)(lbase + m * 16 * 528 + n * 32) = w; }
        __builtin_amdgcn_sched_barrier(0);
        __syncthreads();
        __builtin_amdgcn_sched_barrier(0);
        const int g = lane >> 5, j32 = lane & 31;
#pragma unroll
        for (int ib = 0; ib < 4; ++ib) {
            __builtin_amdgcn_sched_barrier(0);
            u32x4 xv[4];
#pragma unroll
            for (int u = 0; u < 4; ++u) {
                const long row = (long)pm * 256 + (ib * 4 + u) * 16 + wid * 2 + g;
                xv[u] = *(const u32x4*)(xold + row * 1024 + pn * 256 + j32 * 8);
            }
#pragma unroll
            for (int u = 0; u < 4; ++u) {
                const int rloc = (ib * 4 + u) * 16 + wid * 2 + g;
                const long row = (long)pm * 256 + rloc;
                const u32x4 a = *(const u32x4*)(lds + rloc * 528 + j32 * 16);
                u32x4 w; float ss = 0.f;
#pragma unroll
                for (int e = 0; e < 4; ++e) {
                    w[e] = pk2(bflo(xv[u][e]) + bflo(a[e]), bfhi(xv[u][e]) + bfhi(a[e]));
                    const float b0 = bflo(w[e]), b1 = bfhi(w[e]);
                    ss += b0 * b0 + b1 * b1;
                }
                *(u32x4*)(xnew + row * 1024 + pn * 256 + j32 * 8) = w;
#pragma unroll
                for (int o = 1; o < 32; o <<= 1) ss += __shfl_xor(ss, o);
                if (j32 == 0) ssq[row * 4 + pn] = ss;
            }
        }
        __syncthreads();
    }
};
struct EpiQkv {
    static constexpr bool NEEDS_RSTD = true;
    static DI bool swap_tile(int) { return true; }
    bf16_t* qb; bf16_t* kb; bf16_t* vt; const f32x2* rope;
    DI void operator()(gacc_t& acc, int pm, int pn, char* lds, int tid, int wr, int wc, int lane) const {
        asm volatile("" : "+v"(tid), "+v"(lane));
        const int fr = lane & 15, fq = lane >> 4;
        const int R0 = pm * 256;
        const int t0 = R0 < TP ? (R0 & ~4095) : TP + ((R0 - TP) & ~8191);
        const int S = R0 < TP ? 4096 : 8192;
        char* lbase = lds + (wr * 128 + fr) * 528 + (wc * 64 + 4 * fq) * 2;
        const float* rlt = (const float*)(lds + RSTD_OFF) + wr * 128 + fr;
        if (pn < 8) {
            const float sc = pn < 4 ? 0.18033688011112042f : 1.0f;
            const f32x2* rbase = rope + (R0 - t0 + wr * 128 + fr) * 32 + 4 * fq;
#pragma unroll
            for (int m = 0; m < 8; ++m) {
                const float rs = rlt[m * 16] * sc;
#pragma unroll
                for (int n = 0; n < 2; ++n) {
                    const f32x4 c01 = *(const f32x4*)(rbase + m * 16 * 32 + n * 16), c23 = *(const f32x4*)(rbase + m * 16 * 32 + n * 16 + 2);
                    const float cs_[4] = {c01.x, c01.z, c23.x, c23.z}, sn_[4] = {c01.y, c01.w, c23.y, c23.w};
                    float o1[4], o2[4];
#pragma unroll
                    for (int j = 0; j < 4; ++j) {
                        const float x1 = acc[m][n][j], x2 = acc[m][n + 2][j];
                        o1[j] = (x1 * cs_[j] - x2 * sn_[j]) * rs; o2[j] = (x2 * cs_[j] + x1 * sn_[j]) * rs;
                    }
                    u32x2 w1, w2; w1.x = pk2(o1[0], o1[1]); w1.y = pk2(o1[2], o1[3]); w2.x = pk2(o2[0], o2[1]); w2.y = pk2(o2[2], o2[3]);
                    *(u32x2*)(lbase + m * 16 * 528 + n * 32) = w1; *(u32x2*)(lbase + m * 16 * 528 + n * 32 + 64) = w2;
                }
                __builtin_amdgcn_sched_barrier(0);
            }
        } else {
#pragma unroll
            for (int m = 0; m < 8; ++m) {
                const float r = rlt[m * 16];
#pragma unroll
                for (int n = 0; n < 4; ++n) { u32x2 w; w.x = pk2(acc[m][n][0] * r, acc[m][n][1] * r); w.y = pk2(acc[m][n][2] * r, acc[m][n][3] * r); *(u32x2*)(lbase + m * 16 * 528 + n * 32) = w; }
            }
        }
        __syncthreads();
        if (pn < 8) {
            store_tile_from_lds(lds, (pn < 4 ? qb : kb) + (long)R0 * 1024 + (pn & 3) * 256, 1024, tid);
        } else {
            const int e = tid & 255, gh = tid >> 8;
            const int cr = (pn - 8) * 256 + e, head = cr >> 7;
            bf16_t* vrow = vt + (long)t0 * 1024 + (long)(head * 128 + (cr & 127)) * S + (R0 - t0);
            const char* col = lds + e * 2;
#pragma unroll
            for (int g = 0; g < 4; ++g) {
                const int grp = gh * 4 + g;
                unsigned w[16];
#pragma unroll
                for (int pp = 0; pp < 16; ++pp) {
                    const int p0 = 2 * pp, p1 = 2 * pp + 1;
                    const int k0 = 16 * (p0 >> 4) + 8 * ((p0 >> 2) & 1) + 4 * ((p0 >> 3) & 1) + (p0 & 3), k1 = 16 * (p1 >> 4) + 8 * ((p1 >> 2) & 1) + 4 * ((p1 >> 3) & 1) + (p1 & 3);
                    const unsigned lo = *(const bf16_t*)(col + (grp * 32 + k0) * 528), hi = *(const bf16_t*)(col + (grp * 32 + k1) * 528);
                    w[pp] = lo | (hi << 16);
                }
#pragma unroll
                for (int q = 0; q < 4; ++q) { u32x4 o; o.x = w[4 * q]; o.y = w[4 * q + 1]; o.z = w[4 * q + 2]; o.w = w[4 * q + 3]; *(u32x4*)(vrow + grp * 32 + q * 8) = o; }
            }
        }
        __syncthreads();
    }
};
struct EpiFfn {
    static constexpr bool NEEDS_RSTD = true;
    static DI bool swap_tile(int) { return true; }
    const float* cw; const float* cb; bf16_t* act; bf16_t* halo;
    DI void operator()(gacc_t& acc, int pm, int pn, char* lds, int tid, int wr, int wc, int lane) const {
        asm volatile("" : "+v"(tid), "+v"(lane));
        const int fr = lane & 15, fq = lane >> 4;
        constexpr int RS = 528;
        const float* rl = (const float*)(lds + RSTD_OFF) + wr * 128 + fr;
        {
            char* lbase = lds + (wr * 128 + fr) * RS + (wc * 64 + 4 * fq) * 2;
            bf16_t* hrow = halo + (long)(pm * 4) * 5632 + pn * 256 + wc * 64 + 4 * fq;
#pragma unroll
            for (int m = 0; m < 8; ++m) {
                const float r = rl[m * 16];
#pragma unroll
                for (int n = 0; n < 4; ++n) {
                    u32x2 w; w.x = pk2(acc[m][n][0] * r, acc[m][n][1] * r); w.y = pk2(acc[m][n][2] * r, acc[m][n][3] * r);
                    *(u32x2*)(lbase + m * 16 * RS + n * 32) = w;
                    if (m == 0 && wr == 0 && fr < 2) *(u32x2*)(hrow + fr * 5632 + n * 16) = w;
                    if (m == 7 && wr == 1 && fr >= 14) *(u32x2*)(hrow + (fr - 12) * 5632 + n * 16) = w;
                }
            }
        }
        __syncthreads();
        const int cgp = tid & 15, rs = tid >> 4;
        const int jg = pn * 128 + cgp * 8;
        float wg[3][8], wu[3][8], bg[8], bu[8];
#pragma unroll
        for (int t = 0; t < 3; ++t) {
            const f32x4 a0 = *(const f32x4*)(cw + t * 5632 + jg), a1 = *(const f32x4*)(cw + t * 5632 + jg + 4);
            const f32x4 b0 = *(const f32x4*)(cw + t * 5632 + 2816 + jg), b1 = *(const f32x4*)(cw + t * 5632 + 2816 + jg + 4);
#pragma unroll
            for (int e = 0; e < 4; ++e) { wg[t][e] = a0[e]; wg[t][4 + e] = a1[e]; wu[t][e] = b0[e]; wu[t][4 + e] = b1[e]; }
        }
        {
            const f32x4 a0 = *(const f32x4*)(cb + jg), a1 = *(const f32x4*)(cb + jg + 4);
            const f32x4 b0 = *(const f32x4*)(cb + 2816 + jg), b1 = *(const f32x4*)(cb + 2816 + jg + 4);
#pragma unroll
            for (int e = 0; e < 4; ++e) { bg[e] = a0[e]; bg[4 + e] = a1[e]; bu[e] = b0[e]; bu[4 + e] = b1[e]; }
        }
        const char* gbase = lds + ((cgp >> 2) * 64 + (cgp & 3) * 8) * 2;
        const int R0 = pm * 256;
        const bool first = is_seq_start(R0), last = is_seq_start(R0 + 256);
        float pg[8], pu[8], cg_[8], cu[8];
        const int r0 = rs * 8;
        auto ldrow = [&](int row, float (&g)[8], float (&u)[8]) {
            if (row < 0 || row > 255) {
#pragma unroll
                for (int e = 0; e < 8; ++e) { g[e] = 0.f; u[e] = 0.f; }
            } else {
                const u32x4 a = *(const u32x4*)(gbase + row * RS), b = *(const u32x4*)(gbase + row * RS + 64);
                g[0] = bflo(a.x); g[1] = bfhi(a.x); g[2] = bflo(a.y); g[3] = bfhi(a.y); g[4] = bflo(a.z); g[5] = bfhi(a.z); g[6] = bflo(a.w); g[7] = bfhi(a.w);
                u[0] = bflo(b.x); u[1] = bfhi(b.x); u[2] = bflo(b.y); u[3] = bfhi(b.y); u[4] = bflo(b.z); u[5] = bfhi(b.z); u[6] = bflo(b.w); u[7] = bfhi(b.w);
            }
        };
        ldrow(r0 - 1, pg, pu);
        ldrow(r0, cg_, cu);
#pragma unroll
        for (int rr = 0; rr < 8; ++rr) {
            const int row = r0 + rr;
            float ng[8], nu[8];
            ldrow(row + 1, ng, nu);
            float o[8];
#pragma unroll
            for (int e = 0; e < 8; ++e) {
                const float g = bg[e] + wg[0][e] * pg[e] + wg[1][e] * cg_[e] + wg[2][e] * ng[e];
                const float u = bu[e] + wu[0][e] * pu[e] + wu[1][e] * cu[e] + wu[2][e] * nu[e];
                const float sg = g * __builtin_amdgcn_rcpf(1.0f + __builtin_amdgcn_exp2f(-1.4426950408889634f * g));
                o[e] = sg * u;
            }
            const bool skip = (row == 0 && !first) || (row == 255 && !last);
            if (!skip) {
                u32x4 w; w.x = pk2(o[0], o[1]); w.y = pk2(o[2], o[3]); w.z = pk2(o[4], o[5]); w.w = pk2(o[6], o[7]);
                *(u32x4*)(act + (long)(R0 + row) * 2816 + jg) = w;
            }
#pragma unroll
            for (int e = 0; e < 8; ++e) { pg[e] = cg_[e]; pu[e] = cu[e]; cg_[e] = ng[e]; cu[e] = nu[e]; }
        }
        __syncthreads();
    }
};

template <class Epi>
DI void gemm_phase(const bf16_t* A, int lda, const bf16_t* Bt, int ldb, int N, int K, const Epi& epi, const float* ssq, char* lds, int tid) {
    asm volatile("" : "+v"(tid));
    const int wid = tid >> 6, lane = tid & 63, wr = wid >> 2, wc = wid & 3;
    const int nM = T / 256, nN = N / 256;
    for (int it = 0;; ++it) {
        int pm, pn;
        if (!tile_order(it * (int)gridDim.x + (int)blockIdx.x, nM, nN, pm, pn)) break;
        if (Epi::NEEDS_RSTD) __syncthreads();
        gacc_t acc;
        if (Epi::swap_tile(pn)) gemm_tile<Epi::NEEDS_RSTD, true>(acc, A + (long)pm * 256 * lda, lda, Bt + (long)pn * 256 * ldb, ldb, K, lds, tid, wr, wc, lane, ssq + (long)(pm * 256 + (tid & 255)) * 4);
        else gemm_tile<Epi::NEEDS_RSTD, false>(acc, A + (long)pm * 256 * lda, lda, Bt + (long)pn * 256 * ldb, ldb, K, lds, tid, wr, wc, lane, ssq + (long)(pm * 256 + (tid & 255)) * 4);
        epi(acc, pm, pn, lds, tid, wr, wc, lane);
    }
}

DI void convert_T(const float* __restrict__ W, int K, int N, bf16_t* __restrict__ Wt, bool permute, const float* __restrict__ gain, char* lds, int tid) {
    asm volatile("" : "+v"(tid));
    float* tile = (float*)lds;
    const int nnb = N / 64, ntiles = (K / 64) * nnb;
    for (int it = blockIdx.x; it < ntiles; it += gridDim.x) {
        const int k0 = (it / nnb) * 64, n0 = (it % nnb) * 64;
#pragma unroll
        for (int i = 0; i < 8; ++i) { const int idx = tid + NTH * i, kr = idx >> 6, nc = idx & 63; tile[kr * 65 + nc] = W[(long)(k0 + kr) * N + n0 + nc]; }
        __syncthreads();
#pragma unroll
        for (int i = 0; i < 8; ++i) {
            const int idx = tid + NTH * i, nr = idx >> 6, kc = idx & 63; const int n = n0 + nr; int nd = n;
            if (permute) { if (n < 2816) nd = (n >> 5) * 64 + (n & 31); else { const int j = n - 2816; nd = (j >> 5) * 64 + 32 + (j & 31); } }
            Wt[(long)nd * K + k0 + kc] = bf1(tile[kc * 65 + nr] * (gain ? gain[k0 + kc] : 1.0f));
        }
        __syncthreads();
    }
}

template <bool FINAL>
DI void norm_rows(const float* src0, const float* src1, const float* __restrict__ g, bf16_t* dst, float* fdst, float* copy, int wid, int lane) {
    asm volatile("" : "+v"(wid), "+v"(lane));
    for (int row = blockIdx.x * 8 + wid; row < T; row += gridDim.x * 8) {
        const float* xr = row < TP ? src0 + (long)row * 1024 : src1 + (long)(row - TP) * 1024;
        f32x4 v[4]; float ss = 0.f;
#pragma unroll
        for (int j = 0; j < 4; ++j) { v[j] = ((const f32x4*)xr)[lane + 64 * j]; ss += (v[j].x * v[j].x + v[j].y * v[j].y) + (v[j].z * v[j].z + v[j].w * v[j].w); }
        ss = wave_sum(ss);
        const float rstd = 1.0f / sqrtf(ss * (1.0f / 1024.0f) + 1e-6f);
#pragma unroll
        for (int j = 0; j < 4; ++j) {
            if (copy) ((f32x4*)(copy + (long)row * 1024))[lane + 64 * j] = v[j];
            const f32x4 gg = ((const f32x4*)g)[lane + 64 * j];
            const f32x4 o = v[j] * rstd * gg;
            if (FINAL) ((f32x4*)(fdst + (long)row * 1024))[lane + 64 * j] = o;
            else { u32x2 w; w.x = pk2(o.x, o.y); w.y = pk2(o.z, o.w); ((u32x2*)(dst + (long)row * 1024))[lane + 64 * j] = w; }
        }
    }
}

DI void final_norm(const bf16_t* __restrict__ xb, const float* __restrict__ g, float* __restrict__ out, int wid, int lane) {
    asm volatile("" : "+v"(wid), "+v"(lane));
    for (int row = blockIdx.x * 8 + wid; row < T; row += gridDim.x * 8) {
        const u32x4 a = *(const u32x4*)(xb + (long)row * 1024 + lane * 16), b = *(const u32x4*)(xb + (long)row * 1024 + lane * 16 + 8);
        float v[16];
#pragma unroll
        for (int e = 0; e < 4; ++e) { v[2 * e] = bflo(a[e]); v[2 * e + 1] = bfhi(a[e]); v[8 + 2 * e] = bflo(b[e]); v[8 + 2 * e + 1] = bfhi(b[e]); }
        float ss = 0.f;
#pragma unroll
        for (int e = 0; e < 16; ++e) ss += v[e] * v[e];
        ss = wave_sum(ss);
        const float rstd = 1.0f / sqrtf(ss * (1.0f / 1024.0f) + 1e-6f);
#pragma unroll
        for (int q = 0; q < 4; ++q) {
            const f32x4 gg = *(const f32x4*)(g + lane * 16 + q * 4);
            f32x4 o; o.x = v[4 * q] * rstd * gg.x; o.y = v[4 * q + 1] * rstd * gg.y; o.z = v[4 * q + 2] * rstd * gg.z; o.w = v[4 * q + 3] * rstd * gg.w;
            *(f32x4*)(out + (long)row * 1024 + lane * 16 + q * 4) = o;
        }
    }
}

DI void spatial_phase(const bf16_t* __restrict__ z, const bf16_t* __restrict__ wsb, const float* __restrict__ vgain, const float* __restrict__ bs,
                      bf16_t* __restrict__ y, char* lds, int tid, int wid, int lane) {
    float* srstd = (float*)(lds + 65536);
    char* la = lds; char* lb = lds + 32768;
    for (int unit = blockIdx.x; unit < T / 64; unit += gridDim.x) {
        asm volatile("" : "+v"(tid)); wid = tid >> 6; lane = tid & 63;
        const int l31 = lane & 31, hh = lane >> 5;
        const int wr = wid >> 1, wc = wid & 1;
        const long t0 = (long)(unit >> 1) * 128;
        const int g0 = (unit & 1) * 4;
#pragma unroll
        for (int rb = 0; rb < 4; ++rb) {
            u32x4 va[4], vb[4];
#pragma unroll
            for (int r = 0; r < 4; ++r) {
                const bf16_t* vr = z + (t0 + wid * 16 + rb * 4 + r) * 2048 + 1024 + lane * 16;
                va[r] = *(const u32x4*)vr; vb[r] = *(const u32x4*)(vr + 8);
            }
#pragma unroll
            for (int r = 0; r < 4; ++r) {
                float ss = 0.f;
#pragma unroll
                for (int e = 0; e < 4; ++e) { const float x0 = bflo(va[r][e]), x1 = bfhi(va[r][e]), x2 = bflo(vb[r][e]), x3 = bfhi(vb[r][e]); ss += (x0 * x0 + x1 * x1) + (x2 * x2 + x3 * x3); }
                ss = wave_sum(ss);
                if (lane == 0) srstd[wid * 16 + rb * 4 + r] = 1.0f / sqrtf(ss * (1.0f / 1024.0f) + 1e-6f);
            }
        }
        __syncthreads();
        for (int g = g0; g < g0 + 4; ++g) {
#pragma unroll
            for (int i = 0; i < 4; ++i) {
                const int id = tid + NTH * i, row = id >> 4, ch = id & 15;
                const u32x4 w = *(const u32x4*)(wsb + (long)(g * 128 + row) * 128 + ch * 8);
                *(u32x4*)(la + (ch >> 3) * 16384 + swz(row, ch & 7)) = w;
                const int q = row, d0 = ch * 8;
                const u32x4 vv = *(const u32x4*)(z + (t0 + q) * 2048 + 1024 + g * 128 + d0);
                const float rsq = srstd[q];
                const f32x4 g0 = *(const f32x4*)(vgain + g * 128 + d0), g1 = *(const f32x4*)(vgain + g * 128 + d0 + 4);
                float vals[8];
                vals[0] = bflo(vv.x) * rsq * g0.x; vals[1] = bfhi(vv.x) * rsq * g0.y; vals[2] = bflo(vv.y) * rsq * g0.z; vals[3] = bfhi(vv.y) * rsq * g0.w;
                vals[4] = bflo(vv.z) * rsq * g1.x; vals[5] = bfhi(vv.z) * rsq * g1.y; vals[6] = bflo(vv.w) * rsq * g1.z; vals[7] = bfhi(vv.w) * rsq * g1.w;
                char* dstb = lb + (q >> 6) * 16384 + (q & 7) * 2;
                const int qc = (q & 63) >> 3;
#pragma unroll
                for (int e = 0; e < 8; ++e) *(bf16_t*)(dstb + swz(d0 + e, qc)) = bf1(vals[e]);
            }
            __syncthreads();
            f32x16 acc[2];
#pragma unroll
            for (int n = 0; n < 2; ++n)
#pragma unroll
                for (int i = 0; i < 16; ++i) acc[n][i] = 0.f;
#pragma unroll
            for (int kh = 0; kh < 2; ++kh)
#pragma unroll
                for (int s = 0; s < 4; ++s) {
                    const bf16x8 af = ldfrag(la + kh * 16384, wr * 32 + l31, 2 * s + hh);
#pragma unroll
                    for (int n = 0; n < 2; ++n) { const bf16x8 bfr = ldfrag(lb + kh * 16384, wc * 64 + n * 32 + l31, 2 * s + hh); acc[n] = MFMA(af, bfr, acc[n]); }
                }
            char* vt_ = lds + 66048;
#pragma unroll
            for (int n = 0; n < 2; ++n)
#pragma unroll
                for (int i = 0; i < 16; ++i) {
                    const int p = wr * 32 + crow(i, hh), d = wc * 64 + n * 32 + l31;
                    *(bf16_t*)(vt_ + p * 272 + d * 2) = bf1(acc[n][i] + bs[g * 128 + p]);
                }
            __syncthreads();
#pragma unroll
            for (int k = 0; k < 4; ++k) {
                const int id = tid + NTH * k, p = id >> 4, ch = id & 15;
                const u32x4 uu = *(const u32x4*)(z + (t0 + p) * 2048 + g * 128 + ch * 8);
                const u32x4 vv = *(const u32x4*)(vt_ + p * 272 + ch * 16);
                u32x4 o;
#pragma unroll
                for (int e = 0; e < 4; ++e) o[e] = pk2(bflo(uu[e]) * bflo(vv[e]), bfhi(uu[e]) * bfhi(vv[e]));
                *(u32x4*)(y + (t0 + p) * 1024 + g * 128 + ch * 8) = o;
            }
            __syncthreads();
        }
    }
}

DI void attn_phase(const bf16_t* __restrict__ qb, const bf16_t* __restrict__ kb, const bf16_t* __restrict__ vt, bf16_t* __restrict__ ob,
                   const float* lq1, const float* lk1, const float* lq2, const float* lk2, const float* __restrict__ subg, float lam_init,
                   char* lds, int tid, int wid, int lane) {
    asm volatile("" : "+v"(tid)); wid = tid >> 6; lane = tid & 63;
    const int c = wid & 1, qs = wid >> 1, l31 = lane & 31, hh = lane >> 5;
    const float d1 = wave_sum(lq1[lane] * lk1[lane]), d2 = wave_sum(lq2[lane] * lk2[lane]);
    const float lam = expf(d1) - expf(d2) + lam_init;
    const int srow = tid >> 3, sch = tid & 7;
    const int wv = __builtin_amdgcn_readfirstlane(tid >> 6);
    LAS char* l3 = (LAS char*)lds;
    for (int u = blockIdx.x; u < 5120; u += gridDim.x) {
        int seq, head, qblk;
        if (u < 4096) { const int r = u >> 8, b = u & 255, x = b & 7, lb = b >> 3, p = (r >> 1) * 8 + x; seq = 4 + (p >> 3); head = p & 7; qblk = (r & 1) * 32 + lb; }
        else { const int v = u - 4096, r = v >> 8, b = v & 255, x = b & 7, lb = b >> 3, p = r * 8 + x; seq = p >> 3; head = p & 7; qblk = lb; }
        const int S = seq < 4 ? 4096 : 8192;
        const long t0 = seq < 4 ? (long)seq * 4096 : (long)TP + (long)(seq - 4) * 8192;
        const long qrow_t = t0 + qblk * 128 + qs * 32 + l31;
        bf16x8 qf[4];
        {
            const bf16_t* qrow = qb + qrow_t * 1024 + (head * 2 + c) * 64 + 8 * hh;
#pragma unroll
            for (int s = 0; s < 4; ++s) qf[s] = *(const bf16x8*)(qrow + 16 * s);
        }
        const int cl = sch ^ ((srow >> 1) & 7);
        const bf16_t* kp = kb + (t0 + srow) * 1024 + head * 128 + cl * 8;
        const bf16_t* vp = vt + t0 * 1024 + ((long)head * 128 + srow) * S + cl * 8;
        const int nkt = S / 64;
#define ATT_ISSUE(KT, ST) do { const int kt_ = (KT) < nkt ? (KT) : nkt - 1; LAS char* st_ = l3 + (ST) * 32768 + wv * 1024; \
            const bf16_t* kq_ = kp + (long)kt_ * 64 * 1024; const bf16_t* vq_ = vp + kt_ * 64; \
            __builtin_amdgcn_global_load_lds((const GAS unsigned*)kq_, (LAS unsigned*)st_, 16, 0, 0); \
            __builtin_amdgcn_global_load_lds((const GAS unsigned*)(kq_ + 64), (LAS unsigned*)(st_ + 8192), 16, 0, 0); \
            __builtin_amdgcn_global_load_lds((const GAS unsigned*)vq_, (LAS unsigned*)(st_ + 16384), 16, 0, 0); \
            __builtin_amdgcn_global_load_lds((const GAS unsigned*)(vq_ + (long)64 * S), (LAS unsigned*)(st_ + 24576), 16, 0, 0); } while (0)
        ATT_ISSUE(0, 0); ATT_ISSUE(1, 1); ATT_ISSUE(2, 2);
        f32x16 oacc[4];
#pragma unroll
        for (int ef = 0; ef < 4; ++ef)
#pragma unroll
            for (int i = 0; i < 16; ++i) oacc[ef][i] = 0.f;
        float l_run = 0.f;
        f32x16 negm;
#pragma unroll
        for (int i = 0; i < 16; ++i) negm[i] = 0.f;
        for (int kt = 0; kt < nkt; ++kt) {
            asm volatile("s_waitcnt vmcnt(8)" ::: "memory");
            asm volatile("s_waitcnt lgkmcnt(0)" ::: "memory"); __builtin_amdgcn_s_barrier();
            ATT_ISSUE(kt + 3, (kt + 3) & 3);
            const char* cur = lds + (kt & 3) * 32768;
            const char* kl = cur + c * 8192; const char* vl = cur + 16384;
            f32x16 sacc[2];
            {
                bf16x8 kfr[2][4];
#pragma unroll
                for (int kf = 0; kf < 2; ++kf)
#pragma unroll
                    for (int s = 0; s < 4; ++s) kfr[kf][s] = ldfrag(kl, kf * 32 + l31, 2 * s + hh);
#pragma unroll
                for (int kf = 0; kf < 2; ++kf) {
                    sacc[kf] = MFMA(kfr[kf][0], qf[0], negm);
#pragma unroll
                    for (int s = 1; s < 4; ++s) sacc[kf] = MFMA(kfr[kf][s], qf[s], sacc[kf]);
                }
            }
            bf16x8 vf[2][4];
#pragma unroll
            for (int ef = 0; ef < 4; ++ef) vf[0][ef] = ldfrag(vl, ef * 32 + l31, hh);
            __builtin_amdgcn_sched_group_barrier(0x100, 4, 0);
#pragma unroll
            for (int g_ = 0; g_ < 4; ++g_) { __builtin_amdgcn_sched_group_barrier(0x008, 1, 0); __builtin_amdgcn_sched_group_barrier(0x100, 1, 0); }
            __builtin_amdgcn_sched_group_barrier(0x008, 4, 0);
            __builtin_amdgcn_sched_group_barrier(0x100, 4, 0);
            float mx = fmaxf(fmaxf(sacc[0][0], sacc[0][1]), sacc[0][2]);
#pragma unroll
            for (int i = 3; i < 15; i += 2) mx = fmaxf(fmaxf(mx, sacc[0][i]), sacc[0][i + 1]);
            mx = fmaxf(fmaxf(mx, sacc[0][15]), sacc[1][0]);
#pragma unroll
            for (int i = 1; i < 15; i += 2) mx = fmaxf(fmaxf(mx, sacc[1][i]), sacc[1][i + 1]);
            mx = fmaxf(mx, sacc[1][15]);
            if (kt == 0 || __any(mx > 8.0f)) {
                const float mfull = fmaxf(mx, __shfl_xor(mx, 32));
                const float delta = kt == 0 ? mfull : fmaxf(mfull, 0.f);
                const float alpha = kt == 0 ? 1.0f : __builtin_amdgcn_exp2f(-delta);
                l_run *= alpha;
#pragma unroll
                for (int ef = 0; ef < 4; ++ef)
#pragma unroll
                    for (int i = 0; i < 16; ++i) oacc[ef][i] *= alpha;
#pragma unroll
                for (int i = 0; i < 16; ++i) { negm[i] -= delta; sacc[0][i] -= delta; sacc[1][i] -= delta; }
            }
            float ps = 0.f;
            bf16x8 pq[4];
#define ATT_SOFTQ(Q) do { const int kf_ = (Q) >> 1, s2_ = (Q) & 1; \
                _Pragma("unroll") for (int i = 0; i < 8; ++i) { const float p_ = __builtin_amdgcn_exp2f(sacc[kf_][8 * s2_ + i]); ps += p_; sacc[kf_][8 * s2_ + i] = p_; } \
                u32x4 w_; w_.x = pk2(sacc[kf_][8 * s2_ + 0], sacc[kf_][8 * s2_ + 1]); w_.y = pk2(sacc[kf_][8 * s2_ + 2], sacc[kf_][8 * s2_ + 3]); \
                w_.z = pk2(sacc[kf_][8 * s2_ + 4], sacc[kf_][8 * s2_ + 5]); w_.w = pk2(sacc[kf_][8 * s2_ + 6], sacc[kf_][8 * s2_ + 7]); \
                pq[Q] = __builtin_bit_cast(bf16x8, w_); } while (0)
            ATT_SOFTQ(0);
#pragma unroll
            for (int q = 0; q < 4; ++q) {
                if (q < 3) {
#pragma unroll
                    for (int ef = 0; ef < 4; ++ef) vf[(q + 1) & 1][ef] = ldfrag(vl, ef * 32 + l31, ((q + 1) >> 1) * 4 + 2 * ((q + 1) & 1) + hh);
                    if (q == 0) ATT_SOFTQ(1); else if (q == 1) ATT_SOFTQ(2); else ATT_SOFTQ(3);
                }
#pragma unroll
                for (int ef = 0; ef < 4; ++ef) oacc[ef] = MFMA(vf[q & 1][ef], pq[q], oacc[ef]);
            }
            l_run += ps;
            __builtin_amdgcn_sched_group_barrier(0x002, 20, 0);
#pragma unroll
            for (int g_ = 0; g_ < 12; ++g_) { __builtin_amdgcn_sched_group_barrier(0x008, 1, 0); __builtin_amdgcn_sched_group_barrier(0x100, 1, 0); __builtin_amdgcn_sched_group_barrier(0x002, 5, 0); }
            __builtin_amdgcn_sched_group_barrier(0x008, 4, 0);
        }
        asm volatile("s_waitcnt vmcnt(0)" ::: "memory");
        __syncthreads();
        const float lt = l_run + __shfl_xor(l_run, 32);
        const float inv = 1.0f / lt;
        float* xch = (float*)lds;
        if (c == 1) {
#pragma unroll
            for (int ef = 0; ef < 4; ++ef)
#pragma unroll
                for (int i = 0; i < 16; ++i) xch[((qs * 4 + ef) * 16 + i) * 64 + lane] = oacc[ef][i] * inv;
        }
        __syncthreads();
        if (c == 0) {
            float ss = 0.f;
#pragma unroll
            for (int ef = 0; ef < 4; ++ef)
#pragma unroll
                for (int i = 0; i < 16; ++i) { const float o = oacc[ef][i] * inv - lam * xch[((qs * 4 + ef) * 16 + i) * 64 + lane]; oacc[ef][i] = o; ss += o * o; }
            ss += __shfl_xor(ss, 32);
            const float rstd = (1.0f - lam_init) / sqrtf(ss * (1.0f / 128.0f) + 1e-5f);
            bf16_t* orow = ob + qrow_t * 1024 + head * 128;
#pragma unroll
            for (int ef = 0; ef < 4; ++ef)
#pragma unroll
                for (int g4 = 0; g4 < 4; ++g4) {
                    const int e = ef * 32 + 8 * g4 + 4 * hh;
                    const f32x4 gv = *(const f32x4*)(subg + e);
                    u32x2 w;
                    w.x = pk2(oacc[ef][4 * g4 + 0] * rstd * gv.x, oacc[ef][4 * g4 + 1] * rstd * gv.y);
                    w.y = pk2(oacc[ef][4 * g4 + 2] * rstd * gv.z, oacc[ef][4 * g4 + 3] * rstd * gv.w);
                    *(u32x2*)(orow + e) = w;
                }
        }
        __syncthreads();
    }
}

DI void unpack8(const u32x4 a, float (&f)[8]) {
    f[0] = bflo(a.x); f[1] = bfhi(a.x); f[2] = bflo(a.y); f[3] = bfhi(a.y); f[4] = bflo(a.z); f[5] = bfhi(a.z); f[6] = bflo(a.w); f[7] = bfhi(a.w);
}
DI void ffn_fixup(const bf16_t* halo, const float* cw, const float* cb, bf16_t* act, int tid) {
    asm volatile("" : "+v"(tid));
    const int total = 319 * 2 * 352;
    for (int idx = blockIdx.x * NTH + tid; idx < total; idx += gridDim.x * NTH) {
        const int b = idx / 704, rem = idx - b * 704, which = rem >= 352 ? 1 : 0, jc = rem - which * 352;
        const int R0 = (b + 1) * 256;
        if (is_seq_start(R0)) continue;
        const int j0 = jc * 8;
        const int ng = (j0 >> 5) * 64 + (j0 & 31);
        const bf16_t* hp = halo + (long)(b * 4 + 2 + which) * 5632 + ng;
        float g[3][8], u[3][8];
#pragma unroll
        for (int t = 0; t < 3; ++t) {
            unpack8(*(const u32x4*)(hp + (long)t * 5632), g[t]);
            unpack8(*(const u32x4*)(hp + (long)t * 5632 + 32), u[t]);
        }
        float o[8];
#pragma unroll
        for (int e = 0; e < 8; ++e) {
            const int j = j0 + e;
            const float gg = cb[j] + cw[j] * g[0][e] + cw[5632 + j] * g[1][e] + cw[2 * 5632 + j] * g[2][e];
            const float uu = cb[2816 + j] + cw[2816 + j] * u[0][e] + cw[5632 + 2816 + j] * u[1][e] + cw[2 * 5632 + 2816 + j] * u[2][e];
            o[e] = gg * __builtin_amdgcn_rcpf(1.0f + __builtin_amdgcn_exp2f(-1.4426950408889634f * gg)) * uu;
        }
        u32x4 w; w.x = pk2(o[0], o[1]); w.y = pk2(o[2], o[3]); w.z = pk2(o[4], o[5]); w.w = pk2(o[6], o[7]);
        *(u32x4*)(act + (long)(R0 - 1 + which) * 2816 + j0) = w;
    }
}

DI float dot8(const u32x4 a, const u32x4 b) {
    float s = 0.f;
#pragma unroll
    for (int e = 0; e < 4; ++e) s += bflo(a[e]) * bflo(b[e]) + bfhi(a[e]) * bfhi(b[e]);
    return s;
}
DI void ffn_fixup2(const bf16_t* __restrict__ hb, const bf16_t* __restrict__ wfin, const float* __restrict__ cw, const float* __restrict__ cb, bf16_t* __restrict__ act, int tid) {
    asm volatile("" : "+v"(tid));
    const int total = 319 * 2 * 2816;
    for (int idx = blockIdx.x * NTH + tid; idx < total; idx += gridDim.x * NTH) {
        const int b = idx / 5632, rem = idx % 5632, which = rem / 2816, j = rem % 2816;
        const int R0 = (b + 1) * 256;
        if (is_seq_start(R0)) continue;
        const int ng = (j >> 5) * 64 + (j & 31), nu = ng + 32;
        const int r = R0 - 1 + which;
        const bf16_t* h0 = hb + (long)(r - 1) * 1024; const bf16_t* h1 = h0 + 1024; const bf16_t* h2 = h1 + 1024;
        const bf16_t* wgp = wfin + (long)ng * 1024; const bf16_t* wup = wfin + (long)nu * 1024;
        float ag0 = 0.f, ag1 = 0.f, ag2 = 0.f, au0 = 0.f, au1 = 0.f, au2 = 0.f;
        for (int k = 0; k < 1024; k += 8) {
            const u32x4 x0 = *(const u32x4*)(h0 + k), x1 = *(const u32x4*)(h1 + k), x2 = *(const u32x4*)(h2 + k);
            const u32x4 g8 = *(const u32x4*)(wgp + k), u8 = *(const u32x4*)(wup + k);
            ag0 += dot8(x0, g8); ag1 += dot8(x1, g8); ag2 += dot8(x2, g8);
            au0 += dot8(x0, u8); au1 += dot8(x1, u8); au2 += dot8(x2, u8);
        }
        const float g = cb[j] + cw[j] * ag0 + cw[5632 + j] * ag1 + cw[2 * 5632 + j] * ag2;
        const float u = cb[2816 + j] + cw[2816 + j] * au0 + cw[5632 + 2816 + j] * au1 + cw[2 * 5632 + 2816 + j] * au2;
        const float sg = g * __builtin_amdgcn_rcpf(1.0f + __builtin_amdgcn_exp2f(-1.4426950408889634f * g));
        act[(long)r * 2816 + j] = bf1(sg * u);
    }
}


#define XB_TMO      128
#define XB_XCNT(j)  (256  + 64 * (j))
#define XB_XSUB(j)  (1280 + 64 * (j))
#define XB_XGEN(j)  (2304 + 64 * (j))
#define XB_TOP      3328
#define XB_TOPGEN   3392
#define XCD_BAR_WORDS 3456
#define XB_SPIN_CAP (1u << 18)
DI unsigned xb_ld(unsigned* p)              { return __hip_atomic_load(p, __ATOMIC_RELAXED, __HIP_MEMORY_SCOPE_AGENT); }
DI unsigned xb_add(unsigned* p, unsigned v) { return __hip_atomic_fetch_add(p, v, __ATOMIC_RELAXED, __HIP_MEMORY_SCOPE_AGENT); }
DI unsigned xb_xcc_id() { return (unsigned)__builtin_amdgcn_s_getreg((3 << 11) | 20) & 0xFu; }
#define XB_SPIN(cond, bar) do { unsigned _sp = 0; while (cond) { __builtin_amdgcn_s_sleep(1); \
    if ((++_sp & 255u) == 0u) { if (xb_ld(&(bar)[XB_TMO])) break; if (_sp > XB_SPIN_CAP) { atomicAdd(&(bar)[XB_TMO], 1u); break; } } } } while (0)
struct XcdBarrier { unsigned* bar; unsigned x; volatile LAS unsigned* st; };
DI XcdBarrier xcd_barrier_post(unsigned* bar, volatile LAS unsigned* st) {
    XcdBarrier b; b.bar = bar; b.x = xb_xcc_id(); b.st = st;
    if (threadIdx.x == 0) (void)xb_add(&bar[XB_XCNT(b.x)], 1u);
    return b;
}
DI void xcd_barrier_complete(unsigned* bar, unsigned x, unsigned& nloc, unsigned& nx) {
    const unsigned G = gridDim.x * gridDim.y * gridDim.z;
    unsigned sum, cnt, mine, sp = 0u;
    for (;;) {
        sum = 0u; cnt = 0u; mine = 0u;
#pragma unroll
        for (unsigned j = 0; j < 16; ++j) { const unsigned c = xb_ld(&bar[XB_XCNT(j)]); sum += c; cnt += (c > 0u) ? 1u : 0u; mine = (j == x) ? c : mine; }
        if (sum == G) break;
        __builtin_amdgcn_s_sleep(1);
        if ((++sp & 255u) == 0u) { if (xb_ld(&bar[XB_TMO])) break; if (sp > XB_SPIN_CAP) { atomicAdd(&bar[XB_TMO], 1u); break; } }
    }
    nloc = mine > 0u ? mine : 1u; nx = cnt > 0u ? cnt : 1u;
}
DI void xcd_barrier(const XcdBarrier& b) {
    asm volatile("s_waitcnt vmcnt(0)" ::: "memory");
    __syncthreads();
    if (threadIdx.x == 0) {
        unsigned* bar = b.bar;
        __builtin_amdgcn_s_waitcnt(0);
        unsigned nloc = b.st[0], nx = b.st[1];
        if (nloc == 0u) { xcd_barrier_complete(bar, b.x, nloc, nx); b.st[0] = nloc; b.st[1] = nx; }
        const unsigned old = xb_add(&bar[XB_XSUB(b.x)], 1u);
        const unsigned gen = old / nloc;
        if (old + 1u == (gen + 1u) * nloc) {
            __builtin_amdgcn_fence(__ATOMIC_RELEASE, "agent");
            asm volatile("s_waitcnt vmcnt(0)" ::: "memory");
            const unsigned og = xb_add(&bar[XB_TOP], 1u);
            const unsigned tg = og / nx;
            if (og + 1u == (tg + 1u) * nx) xb_add(&bar[XB_TOPGEN], 1u);
            else XB_SPIN(xb_ld(&bar[XB_TOPGEN]) == tg, bar);
            __builtin_amdgcn_fence(__ATOMIC_ACQUIRE, "agent");
            xb_add(&bar[XB_XGEN(b.x)], 1u);
            asm volatile("s_waitcnt vmcnt(0)" ::: "memory");
        } else {
            XB_SPIN(xb_ld(&bar[XB_XGEN(b.x)]) == gen, bar);
            __builtin_amdgcn_fence(__ATOMIC_ACQUIRE, "agent");
            asm volatile("s_waitcnt vmcnt(0)" ::: "memory");
        }
    }
    __syncthreads();
}
#define GSYNC_CG() do { asm volatile("s_waitcnt vmcnt(0)" ::: "memory"); grid.sync(); } while (0)
#define GSYNC() do { XcdBarrier xb_; xb_.bar = (unsigned*)(p.ws + OFF_BAR); xb_.x = xb_xcc_id(); xb_.st = (volatile LAS unsigned*)((LAS char*)lds + XB_LDS_OFF); xcd_barrier(xb_); } while (0)
__global__ void __launch_bounds__(512) mega(Params p) {
    extern __shared__ __attribute__((aligned(16))) char lds[];
    cg::grid_group grid = cg::this_grid();
    const int tid = threadIdx.x, wid = tid >> 6, lane = tid & 63;
    char* ws = p.ws;
    if (tid < 4) ((volatile LAS unsigned*)((LAS char*)lds + XB_LDS_OFF))[tid] = 0u;
    __syncthreads();
    (void)xcd_barrier_post((unsigned*)(ws + OFF_BAR), (volatile LAS unsigned*)((LAS char*)lds + XB_LDS_OFF));
    bf16_t* w_gin = (bf16_t*)(ws + OFF_GIN); bf16_t* w_gout = (bf16_t*)(ws + OFF_GOUT); bf16_t* w_gs = (bf16_t*)(ws + OFF_GS);
    bf16_t* w_qkv = (bf16_t*)(ws + OFF_QKV); bf16_t* w_dout = (bf16_t*)(ws + OFF_DOUT); bf16_t* w_fin = (bf16_t*)(ws + OFF_FIN); bf16_t* w_fout = (bf16_t*)(ws + OFF_FOUT);
    f32x2* rope = (f32x2*)(ws + OFF_ROPE);
    bf16_t* hb = (bf16_t*)(ws + OFF_H); bf16_t* big = (bf16_t*)(ws + OFF_BIG); bf16_t* halo = (bf16_t*)(ws + OFF_HALO);
    bf16_t* yo = (bf16_t*)p.out;

    bf16_t* hb2 = (bf16_t*)(ws + OFF_H2); float* ssq = (float*)(ws + OFF_SSQ);
    for (int j = 0; j < 2; ++j) {
        convert_T(p.in[5] + (long)j * 1024 * 2048, 1024, 2048, w_gin + (long)j * 2048 * 1024, false, p.in[2] + (2 * j) * 1024, lds, tid);
        convert_T(p.in[9] + (long)j * 1024 * 1024, 1024, 1024, w_gout + (long)j * 1024 * 1024, false, nullptr, lds, tid);
        convert_T(p.in[10] + (long)j * 1024 * 3072, 1024, 3072, w_qkv + (long)j * 3072 * 1024, false, p.in[2] + (2 * j + 1) * 1024, lds, tid);
        convert_T(p.in[16] + (long)j * 1024 * 1024, 1024, 1024, w_dout + (long)j * 1024 * 1024, false, nullptr, lds, tid);
    }
    for (int j = 0; j < 4; ++j) {
        convert_T(p.in[17] + (long)j * 1024 * 5632, 1024, 5632, w_fin + (long)j * 5632 * 1024, true, p.in[3] + j * 1024, lds, tid);
        convert_T(p.in[20] + (long)j * 2816 * 1024, 2816, 1024, w_fout + (long)j * 1024 * 2816, false, nullptr, lds, tid);
    }
    for (int idx = blockIdx.x * NTH + tid; idx < 2 * 8 * 128 * 128; idx += gridDim.x * NTH) w_gs[idx] = bf1(p.in[7][idx]);
    for (int idx = blockIdx.x * NTH + tid; idx < 8192 * 32; idx += gridDim.x * NTH) {
        const int pos = idx >> 5, i = idx & 31;
        const float ang = (float)pos * p.inv_freq[i];
        const double a = (double)ang;
        const double n = rint(a * 0.15915494309189535);
        double r = fma(-n, 6.283185307179586, a);
        r = fma(-n, 2.4492935982947064e-16, r);
        const float rf = (float)r;
        f32x2 cs; cs.x = cosf(rf); cs.y = sinf(rf);
        rope[idx] = cs;
    }
    for (int row = blockIdx.x * 8 + wid; row < T; row += gridDim.x * 8) {
        const float* xr = row < TP ? p.in[0] + (long)row * 1024 : p.in[1] + (long)(row - TP) * 1024;
        float ss = 0.f;
#pragma unroll
        for (int jj = 0; jj < 4; ++jj) {
            const f32x4 v = ((const f32x4*)xr)[lane + 64 * jj];
            u32x2 w; w.x = pk2(v.x, v.y); w.y = pk2(v.z, v.w);
            ((u32x2*)(hb + (long)row * 1024))[lane + 64 * jj] = w;
            const float a0 = bflo(w.x), a1 = bfhi(w.x), a2 = bflo(w.y), a3 = bfhi(w.y);
            ss += (a0 * a0 + a1 * a1) + (a2 * a2 + a3 * a3);
        }
        ss = wave_sum(ss);
        if (lane == 0) { f32x4 q = {ss, 0.f, 0.f, 0.f}; *(f32x4*)(ssq + (long)row * 4) = q; }
    }
    GSYNC_CG();

    for (int layer = 0; layer < 4; ++layer) {
        const int j = layer >> 1;
        char* wsl = p.ws; asm volatile("" : "+s"(wsl));
        bf16_t* w_gin = (bf16_t*)(wsl + OFF_GIN); bf16_t* w_gout = (bf16_t*)(wsl + OFF_GOUT); bf16_t* w_gs = (bf16_t*)(wsl + OFF_GS);
        bf16_t* w_qkv = (bf16_t*)(wsl + OFF_QKV); bf16_t* w_dout = (bf16_t*)(wsl + OFF_DOUT); bf16_t* w_fin = (bf16_t*)(wsl + OFF_FIN); bf16_t* w_fout = (bf16_t*)(wsl + OFF_FOUT);
        f32x2* rope = (f32x2*)(wsl + OFF_ROPE);
        bf16_t* hb = (bf16_t*)(wsl + OFF_H); bf16_t* big = (bf16_t*)(wsl + OFF_BIG); bf16_t* halo = (bf16_t*)(wsl + OFF_HALO);
        bf16_t* hb2 = (bf16_t*)(wsl + OFF_H2); float* ssq = (float*)(wsl + OFF_SSQ);
        bf16_t* yo = (bf16_t*)p.out; asm volatile("" : "+s"(yo));
        if ((layer & 1) == 0) {
            { EpiGelu e{big}; gemm_phase(hb, 1024, w_gin + (long)j * 2048 * 1024, 1024, 2048, 1024, e, ssq, lds, tid); }
            GSYNC();
            spatial_phase(big, w_gs + (long)j * 8 * 128 * 128, p.in[6] + j * 1024, p.in[8] + j * 1024, yo, lds, tid, wid, lane);
            GSYNC();
            { EpiResid e{hb, hb2, ssq}; gemm_phase(yo, 1024, w_gout + (long)j * 1024 * 1024, 1024, 1024, 1024, e, ssq, lds, tid); }
            GSYNC();
        } else {
            bf16_t* qb = big; bf16_t* kb = big + (long)T * 1024; bf16_t* vt = big + (long)T * 2048;
            { EpiQkv e{qb, kb, vt, rope}; gemm_phase(hb, 1024, w_qkv + (long)j * 3072 * 1024, 1024, 3072, 1024, e, ssq, lds, tid); }
            GSYNC();
            const float lam_init = 0.8f - 0.6f * expf(-0.3f * (float)layer);
            attn_phase(qb, kb, vt, yo, p.in[11] + j * 64, p.in[12] + j * 64, p.in[13] + j * 64, p.in[14] + j * 64, p.in[15] + j * 128, lam_init, lds, tid, wid, lane);
            GSYNC();
            { EpiResid e{hb, hb2, ssq}; gemm_phase(yo, 1024, w_dout + (long)j * 1024 * 1024, 1024, 1024, 1024, e, ssq, lds, tid); }
            GSYNC();
        }
        { EpiFfn e{p.in[18] + (long)layer * 3 * 5632, p.in[19] + (long)layer * 5632, big, halo};
          gemm_phase(hb2, 1024, w_fin + (long)layer * 5632 * 1024, 1024, 5632, 1024, e, ssq, lds, tid); }
        GSYNC();
        ffn_fixup(halo, p.in[18] + (long)layer * 3 * 5632, p.in[19] + (long)layer * 5632, big, tid);
        GSYNC();
        { EpiResid e{hb2, hb, ssq}; gemm_phase(big, 2816, w_fout + (long)layer * 1024 * 2816, 2816, 1024, 2816, e, ssq, lds, tid); }
        GSYNC();
    }
    {
        int t_end = threadIdx.x; asm volatile("" : "+v"(t_end));
        char* wse = p.ws; asm volatile("" : "+s"(wse));
        final_norm((const bf16_t*)(wse + OFF_H), p.in[4], p.out, t_end >> 6, t_end & 63);
    }
}

extern "C" void kernel_launch(void* const* d_in, const int* in_sizes, int n_in, void* d_out, int out_size, void* d_ws, size_t ws_size,
                              hipStream_t stream) {
    static int grid_blocks = 0;
    if (grid_blocks == 0) {
        if (n_in != 21 || out_size != T * D || ws_size < WS_END) { fprintf(stderr, "kernel_launch: unexpected sizes n_in %d out %d ws %zu (need %zu)\n", n_in, out_size, ws_size, (size_t)WS_END); grid_blocks = -1; return; }
        int dev = 0, cus = 0, per_cu = 0;
        hipGetDevice(&dev);
        hipDeviceGetAttribute(&cus, hipDeviceAttributeMultiprocessorCount, dev);
        hipFuncSetAttribute((const void*)mega, hipFuncAttributeMaxDynamicSharedMemorySize, LDS_BYTES);
        hipOccupancyMaxActiveBlocksPerMultiprocessor(&per_cu, (const void*)mega, NTH, LDS_BYTES);
        if (per_cu < 1) { fprintf(stderr, "kernel_launch: occupancy query says %d blocks/CU\n", per_cu); per_cu = 1; }
        grid_blocks = cus * per_cu;
        (void)hipGetLastError();
    }
    if (grid_blocks < 0) return;
    Params p{};
    for (int i = 0; i < 21; ++i) p.in[i] = (const float*)d_in[i];
    p.out = (float*)d_out; p.ws = (char*)d_ws;
    for (int i = 0; i < 32; ++i) p.inv_freq[i] = (float)pow(10000.0, -(double)i / 32.0);
    (void)hipMemsetAsync((char*)d_ws + OFF_BAR, 0, 3456 * 4, stream);
    void* args[] = {&p};
    hipError_t e = hipLaunchCooperativeKernel((const void*)mega, dim3(grid_blocks), dim3(NTH), args, LDS_BYTES, stream);
    if (e != hipSuccess) fprintf(stderr, "cooperative launch failed: %s (grid %d)\n", hipGetErrorString(e), grid_blocks);
}
```
